# Optimizing an MI355X kernel written in HIP

```python
import jax, jax.numpy as jnp
from jax import lax

D_MODEL = 1024
BATCH = 8
SEQ = 2048
DEPTH = 4

D_MIX = D_MODEL
FOUR_W = D_MIX // 4
FOUR_HEADS = 4
FOUR_HD = FOUR_W // FOUR_HEADS
GMLP_W = D_MIX // 4
GMLP_HEADS = 4
GMLP_HD = GMLP_W // GMLP_HEADS
GMLP_CHUNK = 128
MLSTM_W = D_MIX - FOUR_W - GMLP_W
MLSTM_HEADS = 4
MLSTM_DV = MLSTM_W // MLSTM_HEADS
MLSTM_DQK = MLSTM_DV // 2
MLSTM_QK_W = MLSTM_HEADS * MLSTM_DQK
MLSTM_CHUNK = 128
CONV_K = 3
N_GATES = 4 * MLSTM_HEADS
SPLIT_SIZES = (FOUR_W, GMLP_W, GMLP_W, 2 * MLSTM_QK_W, MLSTM_W, MLSTM_W, N_GATES)
D_IN = FOUR_W + 2 * GMLP_W + 2 * MLSTM_QK_W + 2 * MLSTM_W + N_GATES
N_EXPERTS = 128
TOP_K = 8
D_EXPERT = D_MODEL // 4
MOE_BLOCK = 128
PLE_DIM = 256
EPS = 1e-6
F_BIAS_INIT = 3.0

kernel_name = "hybrid_fourier_gmlp_mlstm_moe_encoder"


def rmsnorm(x, g):
    xf = x.astype(jnp.float32)
    y = xf * lax.rsqrt(jnp.mean(xf * xf, axis=-1, keepdims=True) + EPS)
    return (y * g.astype(jnp.float32)).astype(x.dtype)


def layernorm(x, g, b):
    xf = x.astype(jnp.float32)
    mu = jnp.mean(xf, axis=-1, keepdims=True)
    xc = xf - mu
    y = xc * lax.rsqrt(jnp.mean(xc * xc, axis=-1, keepdims=True) + EPS)
    return (y * g.astype(jnp.float32) + b.astype(jnp.float32)).astype(x.dtype)


def fourier_mixer(z, w):
    B, S, _ = z.shape
    zh = z.reshape(B, S, FOUR_HEADS, FOUR_HD).astype(jnp.float32)
    f = jnp.fft.fft2(zh, axes=(1, 3), norm="ortho").real
    y = jnp.einsum('bshd,hde->bshe', f.astype(z.dtype), w)
    return y.reshape(B, S, FOUR_W)


def gmlp_mixer(zu, zv, ln_g, ln_b, ws, bs):
    B, S, _ = zu.shape
    u = jax.nn.gelu(zu)
    v = layernorm(jax.nn.gelu(zv), ln_g, ln_b)
    nc = S // GMLP_CHUNK
    vh = v.reshape(B, nc, GMLP_CHUNK, GMLP_HEADS, GMLP_HD)
    s = jnp.einsum('hij,bcjhd->bcihd', ws, vh) + bs.T[None, None, :, :, None]
    return u * s.reshape(B, S, GMLP_W)


def short_conv(x, w):
    C = x.shape[-1]
    return lax.conv_general_dilated(
        x, w[:, None, :], window_strides=(1,),
        padding=[(CONV_K // 2, CONV_K // 2)],
        dimension_numbers=('NWC', 'WIO', 'NWC'), feature_group_count=C)


def mlstm_dir(q, k, v, li, lf):
    B, H, S, DK = q.shape
    DV = v.shape[-1]
    L = MLSTM_CHUNK
    nc = S // L
    q = q.reshape(B, H, nc, L, DK)
    k = k.reshape(B, H, nc, L, DK)
    v = v.reshape(B, H, nc, L, DV)
    li = li.reshape(B, H, nc, L)
    lf = lf.reshape(B, H, nc, L)
    b = jnp.cumsum(lf, axis=-1)
    g = b[..., -1]
    a = g[..., None] - b + li
    m_loc = jnp.max(a, axis=-1)
    w = jnp.exp(a - m_loc[..., None])
    c_loc = jnp.einsum('bhcl,bhcld,bhcle->bhcde', w, k, v)
    n_loc = jnp.einsum('bhcl,bhcld->bhcd', w, k)

    def step(carry, xs):
        c, n, m = carry
        cl, nl, ml, gl = xs
        m_new = jnp.maximum(gl + m, ml)
        a_old = jnp.exp(gl + m - m_new)
        a_new = jnp.exp(ml - m_new)
        c2 = a_old[..., None, None] * c + a_new[..., None, None] * cl
        n2 = a_old[..., None] * n + a_new[..., None] * nl
        return (c2, n2, m_new), (c, n, m)

    init = (jnp.zeros((B, H, DK, DV), jnp.float32),
            jnp.zeros((B, H, DK), jnp.float32),
            jnp.zeros((B, H), jnp.float32))
    mv = lambda t: jnp.moveaxis(t, 2, 0)
    _, (c_prev, n_prev, m_prev) = lax.scan(step, init, (mv(c_loc), mv(n_loc), mv(m_loc), mv(g)))
    c_prev = jnp.moveaxis(c_prev, 0, 2)
    n_prev = jnp.moveaxis(n_prev, 0, 2)
    m_prev = jnp.moveaxis(m_prev, 0, 2)
    lower = jnp.tril(jnp.ones((L, L), dtype=bool))
    dmat = jnp.where(lower, b[..., :, None] - b[..., None, :] + li[..., None, :], -jnp.inf)
    m_intra = jnp.max(dmat, axis=-1)
    m_inter = b + m_prev[..., None]
    m_tot = jnp.maximum(m_intra, m_inter)
    s_mat = jnp.exp(dmat - m_tot[..., None]) * jnp.einsum('bhcjd,bhcsd->bhcjs', q, k)
    inter = jnp.exp(m_inter - m_tot)
    num = (jnp.einsum('bhcjs,bhcse->bhcje', s_mat, v)
           + inter[..., None] * jnp.einsum('bhcjd,bhcde->bhcje', q, c_prev))
    den = jnp.sum(s_mat, axis=-1) + inter * jnp.einsum('bhcjd,bhcd->bhcj', q, n_prev)
    h = num / jnp.maximum(jnp.abs(den), jnp.exp(-m_tot))[..., None]
    return h.reshape(B, H, S, DV)


def mlstm_mixer(zqk, zv, zo, zg, conv_w, gate_b, norm_g):
    B, S, _ = zv.shape
    H = MLSTM_HEADS
    qk = jax.nn.silu(short_conv(zqk, conv_w)).astype(jnp.float32)
    q = qk[..., :MLSTM_QK_W].reshape(B, S, H, MLSTM_DQK).transpose(0, 2, 1, 3) * (MLSTM_DQK ** -0.5)
    k = qk[..., MLSTM_QK_W:].reshape(B, S, H, MLSTM_DQK).transpose(0, 2, 1, 3)
    v = zv.astype(jnp.float32).reshape(B, S, H, MLSTM_DV).transpose(0, 2, 1, 3)
    gts = (zg.astype(jnp.float32) + gate_b.astype(jnp.float32)).reshape(B, S, 4, H).transpose(2, 0, 3, 1)
    i_f, f_f, i_b, f_b = gts[0], gts[1], gts[2], gts[3]
    h_fwd = mlstm_dir(q, k, v, i_f, jax.nn.log_sigmoid(f_f))
    flip = lambda t: jnp.flip(t, axis=2)
    h_bwd = flip(mlstm_dir(flip(q), flip(k), flip(v), flip(i_b), flip(jax.nn.log_sigmoid(f_b))))
    o = jax.nn.sigmoid(zo.astype(jnp.float32)).reshape(B, S, H, MLSTM_DV).transpose(0, 2, 1, 3)
    h = o * (h_fwd + h_bwd)
    mu = jnp.mean(h, axis=-1, keepdims=True)
    hc = h - mu
    h = hc * lax.rsqrt(jnp.mean(hc * hc, axis=-1, keepdims=True) + EPS)
    h = h.transpose(0, 2, 1, 3) * norm_g.astype(jnp.float32).reshape(H, MLSTM_DV)
    return h.reshape(B, S, MLSTM_W).astype(zv.dtype)


def swiglu(x, wg, wu, wd):
    return (jax.nn.silu(x @ wg) * (x @ wu)) @ wd


def moe(xm, router_w, router_b, wg, wu, wd, sg, su, sd):
    B, S, D = xm.shape
    T = B * S
    xt = xm.reshape(T, D)
    scores = jax.nn.sigmoid((xt @ router_w).astype(jnp.float32))
    _, idx = lax.top_k(scores + router_b.astype(jnp.float32), TOP_K)
    sel = jnp.take_along_axis(scores, idx, axis=1)
    gates = sel / jnp.sum(sel, axis=-1, keepdims=True)
    N = T * TOP_K
    flat_e = idx.reshape(N)
    flat_tok = jnp.repeat(jnp.arange(T, dtype=jnp.int32), TOP_K)
    flat_g = gates.reshape(N)
    order = jnp.argsort(flat_e)
    se, st, sgate = flat_e[order], flat_tok[order], flat_g[order]
    counts = jnp.bincount(flat_e, length=N_EXPERTS).astype(jnp.int32)
    pcounts = ((counts + MOE_BLOCK - 1) // MOE_BLOCK) * MOE_BLOCK
    offs = jnp.cumsum(counts) - counts
    pend = jnp.cumsum(pcounts)
    poffs = pend - pcounts
    ppos = poffs[se] + (jnp.arange(N, dtype=jnp.int32) - offs[se])
    n_blk = -(-N // MOE_BLOCK) + N_EXPERTS
    P = n_blk * MOE_BLOCK
    pad_tok = jnp.zeros((P,), jnp.int32).at[ppos].set(st)
    pad_g = jnp.zeros((P,), jnp.float32).at[ppos].set(sgate)
    blk_start = jnp.arange(n_blk, dtype=jnp.int32) * MOE_BLOCK
    blk_e = jnp.minimum(jnp.searchsorted(pend, blk_start, side='right'), N_EXPERTS - 1)

    def run_block(args):
        e, tok = args
        return swiglu(xt[tok], wg[e], wu[e], wd[e])

    ys = lax.map(run_block, (blk_e, pad_tok.reshape(n_blk, MOE_BLOCK)))
    routed = jnp.zeros((T, D), xt.dtype).at[pad_tok].add(
        ys.reshape(P, D) * pad_g[:, None].astype(ys.dtype))
    out = routed + swiglu(xt, sg, su, sd)
    return out.reshape(B, S, D)


def setup_inputs(seed: int = 0) -> dict:
    key = jax.random.key(seed)
    ks = jax.random.split(key, 26)
    nrm = lambda k, shape, scale: jax.random.normal(k, shape, jnp.float32) * scale
    gain = lambda k, shape: 1.0 + nrm(k, shape, 0.02)
    H = MLSTM_HEADS
    gate_off = jnp.concatenate([jnp.zeros((H,), jnp.float32), jnp.full((H,), F_BIAS_INIT, jnp.float32),
                                jnp.zeros((H,), jnp.float32), jnp.full((H,), F_BIAS_INIT, jnp.float32)])
    return {
        "x": nrm(ks[0], (BATCH, SEQ, D_MODEL), 1.0),
        "p": nrm(ks[1], (DEPTH, BATCH, SEQ, PLE_DIM), 1.0),
        "norm1_g": gain(ks[2], (DEPTH, D_MODEL)),
        "w_in": nrm(ks[3], (DEPTH, D_MODEL, D_IN), D_MODEL ** -0.5),
        "four_w": nrm(ks[4], (DEPTH, FOUR_HEADS, FOUR_HD, FOUR_HD), FOUR_HD ** -0.5),
        "gmlp_ln_g": gain(ks[5], (DEPTH, GMLP_W)),
        "gmlp_ln_b": nrm(ks[6], (DEPTH, GMLP_W), 0.02),
        "gmlp_ws": nrm(ks[7], (DEPTH, GMLP_HEADS, GMLP_CHUNK, GMLP_CHUNK), GMLP_CHUNK ** -0.5),
        "gmlp_bs": 1.0 + nrm(ks[8], (DEPTH, GMLP_HEADS, GMLP_CHUNK), 0.1),
        "mlstm_conv_w": nrm(ks[9], (DEPTH, CONV_K, 2 * MLSTM_QK_W), CONV_K ** -0.5),
        "mlstm_gate_b": gate_off + nrm(ks[10], (DEPTH, N_GATES), 0.1),
        "mlstm_norm_g": gain(ks[11], (DEPTH, MLSTM_W)),
        "w_out": nrm(ks[12], (DEPTH, D_MIX, D_MODEL), D_MIX ** -0.5),
        "norm2_g": gain(ks[13], (DEPTH, D_MODEL)),
        "router_w": nrm(ks[14], (DEPTH, D_MODEL, N_EXPERTS), D_MODEL ** -0.5),
        "router_b": nrm(ks[15], (DEPTH, N_EXPERTS), 0.01),
        "exp_w_gate": nrm(ks[16], (DEPTH, N_EXPERTS, D_MODEL, D_EXPERT), D_MODEL ** -0.5),
        "exp_w_up": nrm(ks[17], (DEPTH, N_EXPERTS, D_MODEL, D_EXPERT), D_MODEL ** -0.5),
        "exp_w_down": nrm(ks[18], (DEPTH, N_EXPERTS, D_EXPERT, D_MODEL), D_EXPERT ** -0.5),
        "sh_w_gate": nrm(ks[19], (DEPTH, D_MODEL, D_EXPERT), D_MODEL ** -0.5),
        "sh_w_up": nrm(ks[20], (DEPTH, D_MODEL, D_EXPERT), D_MODEL ** -0.5),
        "sh_w_down": nrm(ks[21], (DEPTH, D_EXPERT, D_MODEL), D_EXPERT ** -0.5),
        "ple_w_in": nrm(ks[22], (DEPTH, PLE_DIM, D_MODEL), PLE_DIM ** -0.5),
        "ple_w_gate": nrm(ks[23], (DEPTH, D_MODEL, D_MODEL), D_MODEL ** -0.5),
        "ple_norm_g": gain(ks[24], (DEPTH, D_MODEL)),
        "final_norm_g": gain(ks[25], (D_MODEL,)),
    }


def reference(x, p, norm1_g, w_in, four_w, gmlp_ln_g, gmlp_ln_b, gmlp_ws, gmlp_bs,
              mlstm_conv_w, mlstm_gate_b, mlstm_norm_g, w_out, norm2_g, router_w, router_b,
              exp_w_gate, exp_w_up, exp_w_down, sh_w_gate, sh_w_up, sh_w_down,
              ple_w_in, ple_w_gate, ple_norm_g, final_norm_g):
    split_idx = []
    acc = 0
    for s in SPLIT_SIZES[:-1]:
        acc += s
        split_idx.append(acc)
    h = x
    for i in range(DEPTH):
        a = rmsnorm(h, norm1_g[i])
        z = a @ w_in[i]
        zf, zu, zv, zqk, zmv, zo, zg = jnp.split(z, split_idx, axis=-1)
        mix = jnp.concatenate([
            fourier_mixer(zf, four_w[i]),
            gmlp_mixer(zu, zv, gmlp_ln_g[i], gmlp_ln_b[i], gmlp_ws[i], gmlp_bs[i]),
            mlstm_mixer(zqk, zmv, zo, zg, mlstm_conv_w[i], mlstm_gate_b[i], mlstm_norm_g[i]),
        ], axis=-1)
        h = h + mix @ w_out[i]
        h = h + moe(rmsnorm(h, norm2_g[i]), router_w[i], router_b[i],
                    exp_w_gate[i], exp_w_up[i], exp_w_down[i],
                    sh_w_gate[i], sh_w_up[i], sh_w_down[i])
        e = p[i] @ ple_w_in[i]
        h = h + rmsnorm(jax.nn.sigmoid(h @ ple_w_gate[i]) * e, ple_norm_g[i])
    return rmsnorm(h, final_norm_g)
```

```cpp
#include <hip/hip_runtime.h>
#include <cstdio>
namespace pg8 {
#define PG8_LAS __attribute__((address_space(3)))
typedef unsigned short bf16_t;
typedef short bf16x8 __attribute__((ext_vector_type(8)));
typedef float f32x4 __attribute__((ext_vector_type(4)));
typedef unsigned u32x4 __attribute__((ext_vector_type(4)));
constexpr int BM = 256, BK = 64, HALF = 128, HTB = HALF * BK * 2  , STAGE_BYTES = 8 * HTB, NXCD = 8, WGM = 8;

__host__ __device__ __forceinline__ int lds_byte(int r, int c) { const int st = (r >> 4) * 2 + (c >> 5), rr = r & 15, cc = c & 31, ob = rr * 64 + cc * 2; return st * 1024 + (ob ^ (((ob >> 9) & 1) << 5)); }
__host__ __device__ __forceinline__ void stage_rc(int b, int& R, int& C) { const int st = b / 1024, sb = b % 1024, swz = sb ^ (((sb >> 9) & 1) << 5); R = (st >> 1) * 16 + swz / 64; C = (st & 1) * 32 + (swz % 64) / 2; }
__host__ __device__ __forceinline__ int perm32(int rho) { const int n = rho >> 4, i = rho & 15; return 8 * (i >> 2) + 4 * n + (i & 3); }

struct Unit { int pm, pn; };
struct Gemm { const bf16_t* A; const bf16_t* Bt; int M, N, K; };

struct StaticOrder {
    int nM, nN, nwg, G, c;
    __host__ __device__ void init(int M, int N, int G_, int c_) { nM = M / BM; nN = N / BM; nwg = nM * nN; G = G_; c = c_; }
    __host__ __device__ bool next(int i, Unit& u) const {
        const long L = (long)i * G + c; if (L >= nwg) return false;
        int wgid = (int)L; { const int q = nwg / NXCD, r = nwg % NXCD, xcd = wgid % NXCD, off = wgid / NXCD; wgid = (xcd < r ? xcd * (q + 1) : r * (q + 1) + (xcd - r) * q) + off; }
        const int nig = WGM * nN, gid = wgid / nig, fm = gid * WGM, gsz = (nM - fm) < WGM ? (nM - fm) : WGM;
        u.pm = fm + ((wgid % nig) % gsz); u.pn = (wgid % nig) / gsz; return true;
    }
    __device__ __forceinline__ void a_ready(const Unit&) const {}
    __device__ __forceinline__ void done(const Unit&) const {}
};
__device__ __forceinline__ unsigned cvt_pk_bf16(float lo, float hi) { unsigned r; asm volatile("v_cvt_pk_bf16_f32 %0, %1, %2" : "=v"(r) : "v"(lo), "v"(hi)); return r; }
template <class Epi, class Sched, bool STAMP = false>
__device__ __forceinline__ void gemm_phase(PG8_LAS unsigned char* lds, const Gemm g, const Sched& S, const Epi& E, unsigned long long* stamps) {
    int tid_o = threadIdx.x; asm volatile("" : "+v"(tid_o));
    const int tid = tid_o, wid = __builtin_amdgcn_readfirstlane(tid >> 6), lane = tid & 63, wr = wid >> 2, wc = wid & 3, fr = lane & 15, fq = lane >> 4;
    const int K = g.K, nt = K / BK;
    int ts_lo = 0, ts_hi = 0, nts = 0; const unsigned long long rt_entry = STAMP ? (unsigned long long)wall_clock64() : 0ull;
#define PG8_STAMP() do { if (STAMP && wid == 0 && nts < 64) { const unsigned long long _c = (unsigned long long)clock64(); \
        ts_lo = (lane == nts) ? (int)(unsigned)_c : ts_lo; ts_hi = (lane == nts) ? (int)(unsigned)(_c >> 32) : ts_hi; ++nts; } } while (0)
    PG8_STAMP();
    unsigned voffA[2], voffB[2];
#pragma unroll
    for (int i = 0; i < 2; ++i) { int R, C; stage_rc(tid * 16 + i * 8192, R, C); const int Rb = Epi::PERM ? ((R & ~31) + perm32(R & 31)) : R;
        voffA[i] = (unsigned)(R * K + C) * 2u; voffB[i] = (unsigned)(Rb * K + C) * 2u; }
    const size_t kstep = (size_t)(BK * 2);
    const size_t hstep = (size_t)HALF * K * 2;
    const size_t tstep = 2 * hstep;
    const unsigned ldsw = (unsigned)wid * 1024u;
    const int aoff = lds_byte(wr * 64 + fr, fq * 8), boff = lds_byte(wc * 32 + fr, fq * 8);
#define PG8_SA(b, h) (((b) * 2 + (h)) * HTB)
#define PG8_SB(b, h) ((4 + (b) * 2 + (h)) * HTB)
#define PG8_STAGE(bufoff, gbase, voff) do { _Pragma("unroll") for (int _i = 0; _i < 2; ++_i) \
        __builtin_amdgcn_global_load_lds((const unsigned*)((const char*)(gbase) + (voff)[_i]), (PG8_LAS unsigned*)(lds + (bufoff) + ldsw + _i * 8192), 16, 0, 0); } while (0)
#define PG8_LDA(dst, b, h) do { _Pragma("unroll") for (int m = 0; m < 4; ++m) _Pragma("unroll") for (int k = 0; k < 2; ++k) dst[m][k] = *(const PG8_LAS bf16x8*)(lds + PG8_SA(b, h) + aoff + m * 2048 + k * 1024); } while (0)
#define PG8_LDB(dst, b, h) do { _Pragma("unroll") for (int n = 0; n < 2; ++n) _Pragma("unroll") for (int k = 0; k < 2; ++k) dst[n][k] = *(const PG8_LAS bf16x8*)(lds + PG8_SB(b, h) + boff + n * 2048 + k * 1024); } while (0)
#define PG8_MMA(ai, bj, At, Bt) do { __builtin_amdgcn_s_setprio(1); _Pragma("unroll") for (int m = 0; m < 4; ++m) _Pragma("unroll") for (int n = 0; n < 2; ++n) _Pragma("unroll") for (int k = 0; k < 2; ++k) \
        acc[ai][bj][m][n] = __builtin_amdgcn_mfma_f32_16x16x32_bf16(Bt[n][k], At[m][k], acc[ai][bj][m][n], 0, 0, 0); __builtin_amdgcn_s_setprio(0); } while (0)
#define PG8_WAIT_V(n) asm volatile("s_waitcnt vmcnt(" #n ")" ::: "memory")
#define PG8_WAIT_L(n) asm volatile("s_waitcnt lgkmcnt(" #n ")" ::: "memory")
#define PG8_BAR __builtin_amdgcn_s_barrier()
#define PG8_SCHED __builtin_amdgcn_sched_barrier(0)
    Unit cur, nxt; int ui = 0;
    if (!S.next(0, cur)) return;
    f32x4 acc[2][2][4][2];
#pragma unroll
    for (int a = 0; a < 2; ++a)
#pragma unroll
        for (int b = 0; b < 2; ++b)
#pragma unroll
            for (int m = 0; m < 4; ++m)
#pragma unroll
                for (int n = 0; n < 2; ++n) acc[a][b][m][n] = (f32x4){0.f, 0.f, 0.f, 0.f};
    bf16x8 At[4][2], B0[2][2], B1[2][2];
    const char* cA = (const char*)g.A + (size_t)cur.pm * tstep; const char* cB = (const char*)g.Bt + (size_t)cur.pn * tstep;
    S.a_ready(cur);
    PG8_STAGE(PG8_SB(0, 0), cB, voffB); PG8_STAGE(PG8_SA(0, 0), cA, voffA); PG8_STAGE(PG8_SB(0, 1), cB + hstep, voffB); PG8_STAGE(PG8_SA(0, 1), cA + hstep, voffA);
    if (wr == 1) PG8_BAR;
    PG8_WAIT_V(4); PG8_BAR;
    PG8_STAGE(PG8_SB(1, 0), cB + kstep, voffB); PG8_STAGE(PG8_SA(1, 0), cA + kstep, voffA); PG8_STAGE(PG8_SB(1, 1), cB + hstep + kstep, voffB);
    PG8_WAIT_V(6); PG8_BAR;
    PG8_STAMP();
    for (;;) {
        const bool has_next = S.next(ui + 1, nxt);
        const char* nA = has_next ? (const char*)g.A + (size_t)nxt.pm * tstep : cA; const char* nB = has_next ? (const char*)g.Bt + (size_t)nxt.pn * tstep : cB;
#pragma unroll 1
        for (int t = 0; t < nt; t += 2) {
            const bool last = (t == nt - 2);
            const char* a1 = cA + (size_t)(t + 1) * kstep;
            const char* a2 = last ? nA : cA + (size_t)(t + 2) * kstep; const char* b2 = last ? nB : cB + (size_t)(t + 2) * kstep;
            const char* a3 = a2 + kstep; const char* b3 = b2 + kstep;
            if (last && has_next) S.a_ready(nxt);
            PG8_LDB(B0, 0, 0); PG8_SCHED; PG8_LDA(At, 0, 0); PG8_STAGE(PG8_SA(1, 1), a1 + hstep, voffA);
            PG8_WAIT_L(8); PG8_BAR; PG8_WAIT_L(0); PG8_MMA(0, 0, At, B0); PG8_BAR; PG8_SCHED;
            PG8_LDB(B1, 0, 1); PG8_STAGE(PG8_SB(0, 0), b2, voffB);
            PG8_BAR; PG8_WAIT_L(0); PG8_MMA(0, 1, At, B1); PG8_BAR;
            PG8_LDA(At, 0, 1); PG8_STAGE(PG8_SA(0, 0), a2, voffA);
            PG8_BAR; PG8_WAIT_L(0); PG8_MMA(1, 0, At, B0); PG8_BAR; PG8_SCHED;
            PG8_STAGE(PG8_SB(0, 1), b2 + hstep, voffB);
            PG8_WAIT_V(6); PG8_BAR; PG8_MMA(1, 1, At, B1); PG8_BAR;
            PG8_LDB(B0, 1, 0); PG8_SCHED; PG8_LDA(At, 1, 0); PG8_STAGE(PG8_SA(0, 1), a2 + hstep, voffA);
            PG8_WAIT_L(8); PG8_BAR; PG8_WAIT_L(0); PG8_MMA(0, 0, At, B0); PG8_BAR; PG8_SCHED;
            PG8_LDB(B1, 1, 1); PG8_STAGE(PG8_SB(1, 0), b3, voffB);
            PG8_BAR; PG8_WAIT_L(0); PG8_MMA(0, 1, At, B1); PG8_BAR;
            PG8_LDA(At, 1, 1); PG8_STAGE(PG8_SA(1, 0), a3, voffA);
            PG8_BAR; PG8_WAIT_L(0); PG8_MMA(1, 0, At, B0); PG8_BAR; PG8_SCHED;
            PG8_STAGE(PG8_SB(1, 1), b3 + hstep, voffB);
            PG8_WAIT_V(6); PG8_BAR; PG8_MMA(1, 1, At, B1); PG8_BAR;
        }
        PG8_STAMP();
        if constexpr (!Epi::AFTER_DRAIN) { E(acc, cur, wr, wc, fr, fq); S.done(cur); }
        PG8_STAMP();
        if (!has_next) break;
#pragma unroll
        for (int a = 0; a < 2; ++a)
#pragma unroll
            for (int b = 0; b < 2; ++b)
#pragma unroll
                for (int m = 0; m < 4; ++m)
#pragma unroll
                    for (int n = 0; n < 2; ++n) acc[a][b][m][n] = (f32x4){0.f, 0.f, 0.f, 0.f};
        cur = nxt; cA = nA; cB = nB; ++ui;
    }
    PG8_WAIT_V(0);
    if (wr == 0) PG8_BAR;
    PG8_BAR;
    if constexpr (Epi::AFTER_DRAIN) { E.fused(acc, cur, wr, wc, fr, fq, lds, wid, lane); S.done(cur); }
    PG8_STAMP();
    if (STAMP && wid == 0) { stamps[lane] = lane < nts ? (((unsigned long long)(unsigned)ts_hi << 32) | (unsigned)ts_lo) : 0ull;
        if (lane == 62) stamps[62] = rt_entry; if (lane == 63) stamps[63] = (unsigned long long)wall_clock64(); }
#undef PG8_STAMP
#undef PG8_SA
#undef PG8_SB
#undef PG8_STAGE
#undef PG8_LDA
#undef PG8_LDB
#undef PG8_MMA
#undef PG8_WAIT_V
#undef PG8_WAIT_L
#undef PG8_BAR
#undef PG8_SCHED
}
}

#define XB_TMO      128
#define XB_XCNT(j)  (256  + 64 * (j))
#define XB_XSUB(j)  (1280 + 64 * (j))
#define XB_XGEN(j)  (2304 + 64 * (j))
#define XB_TOP      3328
#define XB_TOPGEN   3392
#define XCD_BAR_WORDS 3456
#define XB_SPIN_CAP (1u << 18)
#define LAS __attribute__((address_space(3)))

__device__ __forceinline__ unsigned xb_ld(unsigned* p)              { return __hip_atomic_load(p, __ATOMIC_RELAXED, __HIP_MEMORY_SCOPE_AGENT); }
__device__ __forceinline__ unsigned xb_add(unsigned* p, unsigned v) { return __hip_atomic_fetch_add(p, v, __ATOMIC_RELAXED, __HIP_MEMORY_SCOPE_AGENT); }
__device__ __forceinline__ unsigned xb_xcc_id() { return (unsigned)__builtin_amdgcn_s_getreg((3 << 11) | 20) & 0xFu; }
#define XB_SPIN(cond, bar) do { unsigned _sp = 0; while (cond) { __builtin_amdgcn_s_sleep(1); \
    if ((++_sp & 255u) == 0u) { if (xb_ld(&(bar)[XB_TMO])) break; if (_sp > XB_SPIN_CAP) { atomicAdd(&(bar)[XB_TMO], 1u); break; } } } } while (0)

struct XcdBarrier {
    unsigned* bar; unsigned x;
    volatile LAS unsigned* st;
};

__device__ __forceinline__ XcdBarrier xcd_barrier_post(unsigned* bar, volatile LAS unsigned* st) {
    XcdBarrier b; b.bar = bar; b.x = xb_xcc_id(); b.st = st;
    if (threadIdx.x == 0) (void)xb_add(&bar[XB_XCNT(b.x)], 1u);
    return b;
}
__device__ __forceinline__ void xcd_barrier_complete(unsigned* bar, unsigned x, unsigned& nloc, unsigned& nx) {
    const unsigned G = gridDim.x * gridDim.y * gridDim.z;
    unsigned sum, cnt, mine, sp = 0u;
    for (;;) {
        sum = 0u; cnt = 0u; mine = 0u;
#pragma unroll
        for (unsigned j = 0; j < 16; ++j) { const unsigned c = xb_ld(&bar[XB_XCNT(j)]); sum += c; cnt += (c > 0u) ? 1u : 0u; mine = (j == x) ? c : mine; }
        if (sum == G) break;
        __builtin_amdgcn_s_sleep(1);
        if ((++sp & 255u) == 0u) { if (xb_ld(&bar[XB_TMO])) break; if (sp > XB_SPIN_CAP) { atomicAdd(&bar[XB_TMO], 1u); break; } }
    }
    nloc = mine > 0u ? mine : 1u; nx = cnt > 0u ? cnt : 1u;
}

__device__ __forceinline__ void xcd_barrier(const XcdBarrier& b) {
    asm volatile("s_waitcnt vmcnt(0)" ::: "memory");
    __syncthreads();
    if (threadIdx.x == 0) {
        unsigned* bar = b.bar;
        __builtin_amdgcn_s_waitcnt(0);
        unsigned nloc = b.st[0], nx = b.st[1];
        if (nloc == 0u) { xcd_barrier_complete(bar, b.x, nloc, nx); b.st[0] = nloc; b.st[1] = nx; }
        const unsigned old = xb_add(&bar[XB_XSUB(b.x)], 1u);
        const unsigned gen = old / nloc;
        if (old + 1u == (gen + 1u) * nloc) {
            __builtin_amdgcn_fence(__ATOMIC_RELEASE, "agent");
            asm volatile("s_waitcnt vmcnt(0)" ::: "memory");
            const unsigned og = xb_add(&bar[XB_TOP], 1u);
            const unsigned tg = og / nx;
            if (og + 1u == (tg + 1u) * nx) xb_add(&bar[XB_TOPGEN], 1u);
            else XB_SPIN(xb_ld(&bar[XB_TOPGEN]) == tg, bar);
            __builtin_amdgcn_fence(__ATOMIC_ACQUIRE, "agent");
            xb_add(&bar[XB_XGEN(b.x)], 1u);
            asm volatile("s_waitcnt vmcnt(0)" ::: "memory");
        } else {
            XB_SPIN(xb_ld(&bar[XB_XGEN(b.x)]) == gen, bar);
            __builtin_amdgcn_fence(__ATOMIC_ACQUIRE, "agent");
            asm volatile("s_waitcnt vmcnt(0)" ::: "memory");
        }
    }
    __syncthreads();
}


#ifndef PHMASK
#define PHMASK 0x1ffff
#endif
#define EN(j) (((PHMASK) >> (j)) & 1)
#ifndef L3MASK
#define L3MASK 7
#endif
#ifndef MK_SPLIT
#define MK_SPLIT 0
#endif

#define GAS __attribute__((address_space(1)))
typedef unsigned short bf16;
typedef unsigned v4u __attribute__((ext_vector_type(4)));
typedef unsigned v2u __attribute__((ext_vector_type(2)));
typedef float f32x4 __attribute__((ext_vector_type(4)));
typedef short bf16x8 __attribute__((ext_vector_type(8)));
using pg8::Unit;

constexpr int T = 16384, D = 1024, SEQ = 2048, NL = 4, DIN = 2320, NE = 128;
constexpr float EPS = 1e-6f;
constexpr int NWAVES = 8, NTHR = 512;
constexpr size_t MiB = 1u << 20;
constexpr size_t WS_CTL = 0, CTL_BYTES = 1 * MiB;
constexpr size_t WS_WIN = 1 * MiB, WS_WPQ = 17 * MiB, WS_WOUT = 21 * MiB, WS_ROUT = 29 * MiB, WS_PLEIN = 31 * MiB, WS_PLEG = 33 * MiB, WS_GWS = 41 * MiB, WS_CSW = 42 * MiB, WS_DFT = 43 * MiB;
constexpr size_t WS_WGU = 64 * MiB, WGU_L = 129 * MiB;
constexpr size_t WS_WD = 580 * MiB, WD_L = 129 * 1024 * 256 * 2;
constexpr size_t WS_H = 838 * MiB, WS_AALL = 902 * MiB, WS_HB = 1254 * MiB, WS_Z = 1286 * MiB, WS_GATES = 1350 * MiB, WS_PQT = 1351 * MiB, WS_MIX = 1367 * MiB;
constexpr size_t WS_CLOC = 1399 * MiB, WS_CPREV = 1431 * MiB, WS_SMALL = 1447 * MiB, WS_LOGIT = 1448 * MiB, WS_TOPK = 1456 * MiB, WS_ACT = 1458 * MiB, WS_E = 1546 * MiB, WS_GE = 1674 * MiB, WS_PB = 1706 * MiB;
constexpr size_t WS_END = 1738 * MiB;
constexpr int AALL_ROWS = 180224;
constexpr int CW_BAR = 4096;
constexpr int CW_CNT = 240000;
static_assert((CW_CNT + 4 * 256) * 4 <= (int)CTL_BYTES && CW_BAR + 64 * XCD_BAR_WORDS <= CW_CNT, "ctl map");
constexpr int LDS_RING = 131072, LDS_TBL = LDS_RING, LDS_MISC = LDS_RING + 1024, LDS_BYTES = 155648;

__device__ __forceinline__ unsigned f2bf(float f) { unsigned u = __float_as_uint(f); return (u + 0x7fffu + ((u >> 16) & 1u)) >> 16; }
__device__ __forceinline__ unsigned pk2(float lo, float hi) { return f2bf(lo) | (f2bf(hi) << 16); }
__device__ __forceinline__ float bf2f(unsigned b) { return __uint_as_float(b << 16); }
__device__ __forceinline__ float bflo(unsigned w) { return __uint_as_float(w << 16); }
__device__ __forceinline__ float bfhi(unsigned w) { return __uint_as_float(w & 0xffff0000u); }
__device__ __forceinline__ float sigmoidf_(float x) { return 1.f / (1.f + __expf(-x)); }
__device__ __forceinline__ float siluf_(float x) { return x / (1.f + __expf(-x)); }
__device__ __forceinline__ float geluf_(float x) { const float t = 1.5957691216f * (x + 0.044715f * x * x * x); return x / (1.f + __expf(-t)); }
__device__ __forceinline__ float logsigf_(float x) { return fminf(x, 0.f) - log1pf(__expf(-fabsf(x))); }
__device__ __forceinline__ float wave_sum(float v) {
#pragma unroll
    for (int o = 1; o < 64; o <<= 1) v += __shfl_xor(v, o);
    return v;
}
__device__ __forceinline__ int otid() { int t = threadIdx.x; asm volatile("" : "+v"(t)); return t; }
#define LDS_FENCE() asm volatile("s_waitcnt lgkmcnt(0)" ::: "memory")
#define MFMA16(a, b, c) __builtin_amdgcn_mfma_f32_16x16x32_bf16((a), (b), (c), 0, 0, 0)

struct StackOrder {
    int nl, nM, nN, G, c;
    __device__ __forceinline__ bool next(int i, Unit& u) const { const int L = i * G + c; if (L >= nl * nM * nN) return false; const int l = L / (nM * nN), r = L % (nM * nN); u.pm = l * nM + r / nN; u.pn = l * nN + r % nN; return true; }
    __device__ __forceinline__ void a_ready(const Unit&) const {}
    __device__ __forceinline__ void done(const Unit&) const {}
};
struct MoeOrder {
    const LAS int* blkoff; int nct, G, c, total;
    __device__ __forceinline__ bool next(int i, Unit& u) const {
        const int L = i * G + c; if (L >= total) return false;
        const int rb = L / nct, ct = L % nct; int eidx = 0;
        if (rb >= 64) { const int q = rb - 64; int lo = 0, hi = 128; while (hi - lo > 1) { const int mid = (lo + hi) >> 1; if (__builtin_amdgcn_readfirstlane(blkoff[mid]) <= q) lo = mid; else hi = mid; } eidx = 1 + lo; }
        u.pm = rb; u.pn = eidx * nct + ct; return true; }
    __device__ __forceinline__ void a_ready(const Unit&) const {}
    __device__ __forceinline__ void done(const Unit&) const {}
};
struct EpiStoreBf16 {
    static constexpr bool PERM = true, AFTER_DRAIN = false;
    bf16* O; int ldc; int cmask;
    __device__ __forceinline__ void operator()(const f32x4 (&acc)[2][2][4][2], const Unit& u, int wr, int wc, int fr, int fq) const {
        const int row0 = u.pm * 256 + wr * 64 + fr, col0 = (u.pn & cmask) * 256 + wc * 32 + 8 * fq;
#pragma unroll
        for (int ai = 0; ai < 2; ++ai)
#pragma unroll
            for (int m = 0; m < 4; ++m) { bf16* rowp = O + (size_t)(row0 + ai * 128 + m * 16) * ldc + col0;
#pragma unroll
                for (int bj = 0; bj < 2; ++bj) { const f32x4 v0 = acc[ai][bj][m][0], v1 = acc[ai][bj][m][1];
                    v4u w; w.x = pk2(v0[0], v0[1]); w.y = pk2(v0[2], v0[3]); w.z = pk2(v1[0], v1[1]); w.w = pk2(v1[2], v1[3]);
                    *(v4u*)(rowp + bj * 128) = w; } }
    }
};
struct EpiPQ {
    static constexpr bool PERM = true, AFTER_DRAIN = false;
    bf16* O;
    __device__ __forceinline__ void operator()(const f32x4 (&acc)[2][2][4][2], const Unit& u, int wr, int wc, int fr, int fq) const {
        const int row0 = u.pm * 256 + wr * 64 + fr, t0 = u.pn * 256 + wc * 32 + 8 * fq;
#pragma unroll
        for (int ai = 0; ai < 2; ++ai)
#pragma unroll
            for (int m = 0; m < 4; ++m) { const int c = row0 + ai * 128 + m * 16;
#pragma unroll
                for (int bj = 0; bj < 2; ++bj) { const int t = t0 + bj * 128, b = t >> 11, s = t & 2047;
                    const f32x4 v0 = acc[ai][bj][m][0], v1 = acc[ai][bj][m][1];
                    v4u w; w.x = pk2(v0[0], v0[1]); w.y = pk2(v0[2], v0[3]); w.z = pk2(v1[0], v1[1]); w.w = pk2(v1[2], v1[3]);
                    *(v4u*)(O + ((size_t)(b * 256 + (c & 255)) * 4096 + (c >> 8) * 2048 + s)) = w; } }
    }
};
struct EpiFourier {
    static constexpr bool PERM = true, AFTER_DRAIN = false;
    bf16* O;
    __device__ __forceinline__ void operator()(const f32x4 (&acc)[2][2][4][2], const Unit& u, int wr, int wc, int fr, int fq) const {
        const int row0 = u.pm * 256 + wr * 64 + fr, c0 = wc * 32 + 8 * fq, b = u.pn;
#pragma unroll
        for (int ai = 0; ai < 2; ++ai)
#pragma unroll
            for (int m = 0; m < 4; ++m) { bf16* rowp = O + (size_t)(b * 2048 + row0 + ai * 128 + m * 16) * 1024 + c0;
#pragma unroll
                for (int bj = 0; bj < 2; ++bj) { const f32x4 v0 = acc[ai][bj][m][0], v1 = acc[ai][bj][m][1];
                    v4u w; w.x = pk2(v0[0], v0[1]); w.y = pk2(v0[2], v0[3]); w.z = pk2(v1[0], v1[1]); w.w = pk2(v1[2], v1[3]);
                    *(v4u*)(rowp + bj * 128) = w; } }
    }
};
struct EpiResid {
    static constexpr bool PERM = false, AFTER_DRAIN = false;
    float* H;
    __device__ __forceinline__ void operator()(const f32x4 (&acc)[2][2][4][2], const Unit& u, int wr, int wc, int fr, int fq) const {
        const int row0 = u.pm * 256 + wr * 64 + fr, col0 = u.pn * 256 + wc * 32 + 4 * fq;
#pragma unroll
        for (int ai = 0; ai < 2; ++ai)
#pragma unroll
            for (int m = 0; m < 4; ++m) { float* rowp = H + (size_t)(row0 + ai * 128 + m * 16) * D + col0;
#pragma unroll
                for (int bj = 0; bj < 2; ++bj)
#pragma unroll
                    for (int n = 0; n < 2; ++n) { f32x4* p = (f32x4*)(rowp + bj * 128 + n * 16); *p = *p + acc[ai][bj][m][n]; } }
    }
};
struct EpiLogits {
    static constexpr bool PERM = false, AFTER_DRAIN = false;
    float* Lg;
    __device__ __forceinline__ void operator()(const f32x4 (&acc)[2][2][4][2], const Unit& u, int wr, int wc, int fr, int fq) const {
        const int row0 = u.pm * 256 + wr * 64 + fr, col0 = wc * 32 + 4 * fq;
#pragma unroll
        for (int ai = 0; ai < 2; ++ai)
#pragma unroll
            for (int m = 0; m < 4; ++m) { float* rowp = Lg + (size_t)(row0 + ai * 128 + m * 16) * 128 + col0;
#pragma unroll
                for (int n = 0; n < 2; ++n) *(f32x4*)(rowp + n * 16) = acc[ai][0][m][n]; }
    }
};
struct EpiSwiglu {
    static constexpr bool PERM = true, AFTER_DRAIN = false;
    bf16* Act;
    __device__ __forceinline__ void operator()(const f32x4 (&acc)[2][2][4][2], const Unit& u, int wr, int wc, int fr, int fq) const {
        const int row0 = u.pm * 256 + wr * 64 + fr, col0 = (u.pn & 1) * 128 + wc * 32 + 8 * fq;
#pragma unroll
        for (int ai = 0; ai < 2; ++ai)
#pragma unroll
            for (int m = 0; m < 4; ++m) { bf16* rowp = Act + (size_t)(row0 + ai * 128 + m * 16) * 256 + col0;
                float o[8];
#pragma unroll
                for (int n = 0; n < 2; ++n)
#pragma unroll
                    for (int i = 0; i < 4; ++i) o[n * 4 + i] = siluf_(acc[ai][0][m][n][i]) * acc[ai][1][m][n][i];
                v4u w; w.x = pk2(o[0], o[1]); w.y = pk2(o[2], o[3]); w.z = pk2(o[4], o[5]); w.w = pk2(o[6], o[7]);
                *(v4u*)rowp = w; }
    }
};
struct EpiPleGate {
    static constexpr bool PERM = true, AFTER_DRAIN = false;
    bf16* GE; const bf16* E;
    __device__ __forceinline__ void operator()(const f32x4 (&acc)[2][2][4][2], const Unit& u, int wr, int wc, int fr, int fq) const {
        const int row0 = u.pm * 256 + wr * 64 + fr, col0 = u.pn * 256 + wc * 32 + 8 * fq;
#pragma unroll
        for (int ai = 0; ai < 2; ++ai)
#pragma unroll
            for (int m = 0; m < 4; ++m) { const size_t off = (size_t)(row0 + ai * 128 + m * 16) * D + col0;
#pragma unroll
                for (int bj = 0; bj < 2; ++bj) { const v4u e = *(const v4u*)(E + off + bj * 128); const f32x4 v0 = acc[ai][bj][m][0], v1 = acc[ai][bj][m][1];
                    v4u w; w.x = pk2(sigmoidf_(v0[0]) * bflo(e.x), sigmoidf_(v0[1]) * bfhi(e.x)); w.y = pk2(sigmoidf_(v0[2]) * bflo(e.y), sigmoidf_(v0[3]) * bfhi(e.y));
                    w.z = pk2(sigmoidf_(v1[0]) * bflo(e.z), sigmoidf_(v1[1]) * bfhi(e.z)); w.w = pk2(sigmoidf_(v1[2]) * bflo(e.w), sigmoidf_(v1[3]) * bfhi(e.w));
                    *(v4u*)(GE + off + bj * 128) = w; } }
    }
};

__device__ __forceinline__ void transpose_item(const float* W, int ldw, int k0, int n0, bf16* dst, int Kd, LAS float* scr, int lane) {
#pragma unroll 8
    for (int i = 0; i < 32; ++i) { const int kk = 2 * i + (lane >> 5); scr[kk * 33 + (lane & 31)] = W[(size_t)(k0 + kk) * ldw + n0 + (lane & 31)]; }
    LDS_FENCE();
    const int c = lane & 7;
#pragma unroll
    for (int j = 0; j < 4; ++j) { const int n = (lane >> 3) + 8 * j; const LAS float* s = scr + (8 * c) * 33 + n;
        v4u o; o.x = pk2(s[0 * 33], s[1 * 33]); o.y = pk2(s[2 * 33], s[3 * 33]); o.z = pk2(s[4 * 33], s[5 * 33]); o.w = pk2(s[6 * 33], s[7 * 33]);
        *(v4u*)(dst + (size_t)n * Kd + 8 * c) = o; }
    LDS_FENCE();
}

struct Ptrs {
    const float *x, *p, *norm1_g, *w_in, *four_w, *gmlp_ln_g, *gmlp_ln_b, *gmlp_ws, *gmlp_bs, *conv_w, *gate_b, *mnorm_g, *w_out, *norm2_g, *router_w, *router_b,
                *ew_gate, *ew_up, *ew_down, *sh_gate, *sh_up, *sh_down, *ple_w_in, *ple_w_gate, *ple_norm_g, *final_g;
    float* out; unsigned char* ws;
};
typedef const __attribute__((address_space(4))) unsigned char* kptr_t;
__device__ __forceinline__ void load_ptrs(Ptrs& P) {
    kptr_t k = (kptr_t)__builtin_amdgcn_kernarg_segment_ptr(); asm volatile("" : "+s"(k));
#define KP(i) (*(const float* const __attribute__((address_space(4)))*)(k + 8 * (i)))
    P.x = KP(0); P.p = KP(1); P.norm1_g = KP(2); P.w_in = KP(3); P.four_w = KP(4); P.gmlp_ln_g = KP(5); P.gmlp_ln_b = KP(6); P.gmlp_ws = KP(7); P.gmlp_bs = KP(8);
    P.conv_w = KP(9); P.gate_b = KP(10); P.mnorm_g = KP(11); P.w_out = KP(12); P.norm2_g = KP(13); P.router_w = KP(14); P.router_b = KP(15);
    P.ew_gate = KP(16); P.ew_up = KP(17); P.ew_down = KP(18); P.sh_gate = KP(19); P.sh_up = KP(20); P.sh_down = KP(21); P.ple_w_in = KP(22); P.ple_w_gate = KP(23);
    P.ple_norm_g = KP(24); P.final_g = KP(25); P.out = (float*)KP(26); P.ws = (unsigned char*)KP(27);
#undef KP
}

__device__ __forceinline__ void phase_p0a(const Ptrs& P, LAS unsigned char* lds, int tid_, int vcu, int G) {
    const int tid = otid(); (void)tid_;
    const int lane = tid & 63, wave = tid >> 6;
    LAS float* scr = (LAS float*)(lds + wave * 16384);
    const int gw = vcu * NWAVES + wave, NGW = G * NWAVES;
    constexpr int NI_WIN = 1024, NI_WOUT = 512, NI_ROUT = 64, NI_PLEIN = 128, NI_PLEG = 512, NI_SH = 384, NI_EXP = 128 * 384, NI_L = NI_WIN + NI_WOUT + NI_ROUT + NI_PLEIN + NI_PLEG + NI_SH + NI_EXP;
    for (int it = gw; it < NL * NI_L; it += NGW) {
        const int l = it / NI_L; int r = it % NI_L;
        if (r >= NI_L - NI_EXP - NI_SH) {
            r -= NI_L - NI_EXP - NI_SH;
            int eidx, q; const float *sg, *su, *sd;
            if (r < NI_SH) { eidx = 0; q = r; sg = P.sh_gate + (size_t)l * 1024 * 256; su = P.sh_up + (size_t)l * 1024 * 256; sd = P.sh_down + (size_t)l * 256 * 1024; }
            else { r -= NI_SH; const int e = r / 384; q = r % 384; eidx = 1 + e; const size_t eo = ((size_t)l * NE + e) * 1024 * 256; sg = P.ew_gate + eo; su = P.ew_up + eo; sd = P.ew_down + eo; }
            if (q < 256) { const int up = q >> 7, qq = q & 127, kb = qq >> 3, nb = qq & 7, n0 = 32 * nb, k0 = 64 * kb;
                bf16* dst = (bf16*)(P.ws + WS_WGU + (size_t)l * WGU_L) + ((size_t)eidx * 512 + 256 * (n0 >> 7) + (n0 & 127) + 128 * up) * 1024 + k0;
                transpose_item(up ? su : sg, 256, k0, n0, dst, 1024, scr, lane); }
            else { const int qq = q - 256, kb = qq >> 5, nb = qq & 31, n0 = 32 * nb, k0 = 64 * kb;
                bf16* dst = (bf16*)(P.ws + WS_WD + (size_t)l * WD_L) + ((size_t)eidx * 1024 + n0) * 256 + k0;
                transpose_item(sd, 1024, k0, n0, dst, 256, scr, lane); }
            continue;
        }
        if (r < NI_WIN) { const int kb = r >> 6, nb = r & 63;
            transpose_item(P.w_in + (size_t)l * 1024 * DIN, DIN, 64 * kb, 256 + 32 * nb, (bf16*)(P.ws + WS_WIN) + ((size_t)l * 2048 + 32 * nb) * 1024 + 64 * kb, 1024, scr, lane); continue; }
        r -= NI_WIN;
        if (r < NI_WOUT) { const int kb = r >> 5, nb = r & 31;
            transpose_item(P.w_out + (size_t)l * 1024 * 1024, 1024, 64 * kb, 32 * nb, (bf16*)(P.ws + WS_WOUT) + ((size_t)l * 1024 + 32 * nb) * 1024 + 64 * kb, 1024, scr, lane); continue; }
        r -= NI_WOUT;
        if (r < NI_ROUT) { const int kb = r >> 2, nb = r & 3;
            transpose_item(P.router_w + (size_t)l * 1024 * 128, 128, 64 * kb, 32 * nb, (bf16*)(P.ws + WS_ROUT) + ((size_t)l * 256 + 32 * nb) * 1024 + 64 * kb, 1024, scr, lane); continue; }
        r -= NI_ROUT;
        if (r < NI_PLEIN) { const int kb = r >> 5, nb = r & 31;
            transpose_item(P.ple_w_in + (size_t)l * 256 * 1024, 1024, 64 * kb, 32 * nb, (bf16*)(P.ws + WS_PLEIN) + ((size_t)l * 1024 + 32 * nb) * 256 + 64 * kb, 256, scr, lane); continue; }
        r -= NI_PLEIN;
        { const int kb = r >> 5, nb = r & 31;
            transpose_item(P.ple_w_gate + (size_t)l * 1024 * 1024, 1024, 64 * kb, 32 * nb, (bf16*)(P.ws + WS_PLEG) + ((size_t)l * 1024 + 32 * nb) * 1024 + 64 * kb, 1024, scr, lane); }
    }
    const size_t gt = (size_t)vcu * NTHR + tid, NGT = (size_t)G * NTHR;
    for (size_t i = gt; i < (size_t)NL * 128 * 1024 / 8; i += NGT) { const size_t l = i / (128 * 128), r = i % (128 * 128); *(v4u*)((bf16*)(P.ws + WS_ROUT) + (l * 256 + 128) * 1024 + r * 8) = (v4u){0u, 0u, 0u, 0u}; }
    for (size_t i = gt; i < (size_t)NL * 4 * 128 * 128 / 2; i += NGT) { const float a = P.gmlp_ws[2 * i], b = P.gmlp_ws[2 * i + 1]; ((unsigned*)(P.ws + WS_GWS))[i] = pk2(a, b); }
    for (size_t i = gt; i < (size_t)2048 * 4096 / 8; i += NGT) { const int so = (int)(i >> 9), k8 = (int)(i & 511) * 8; float v[8];
#pragma unroll
        for (int j = 0; j < 8; ++j) { const int kk = k8 + j, s = kk & 2047; const int mm = (so * s) & 2047; const float ang = (float)mm * (1.0f / 1024.0f); v[j] = (kk < 2048) ? cospif(ang) : -sinpif(ang); }
        v4u w; w.x = pk2(v[0], v[1]); w.y = pk2(v[2], v[3]); w.z = pk2(v[4], v[5]); w.w = pk2(v[6], v[7]); ((v4u*)(P.ws + WS_DFT))[i] = w; }
    for (size_t i = gt; i < (size_t)NL * T * 256 / 8; i += NGT) { const f32x4 a = ((const f32x4*)P.p)[2 * i], b = ((const f32x4*)P.p)[2 * i + 1];
        v4u w; w.x = pk2(a[0], a[1]); w.y = pk2(a[2], a[3]); w.z = pk2(b[0], b[1]); w.w = pk2(b[2], b[3]); ((v4u*)(P.ws + WS_PB))[i] = w; }
    for (size_t i = gt; i < (size_t)NL * 2 * 4 * 64 * 64; i += NGT) { const int e = (int)(i & 63), d = (int)((i >> 6) & 63), h = (int)((i >> 12) & 3), kind = (int)((i >> 14) & 1), l = (int)(i >> 15);
        const float* fw = P.four_w + ((size_t)(l * 4 + h) * 64) * 64 + e; float s = 0.f;
        for (int kp = 0; kp < 64; ++kp) { const float ang = (float)((kp * d) & 63) * (1.0f / 32.0f); s += (kind ? sinpif(ang) : cospif(ang)) * fw[kp * 64]; }
        ((float*)(P.ws + WS_CSW))[i] = s * 0.00276213586f; }
}

__device__ __forceinline__ void phase_p0b_fold(const Ptrs& P, int tid_, int vcu, int G) {
    const int tid = otid(); (void)tid_;
    const size_t gt = (size_t)vcu * NTHR + tid, NGT = (size_t)G * NTHR;
    for (size_t idx = gt; idx < (size_t)NL * 2 * 4 * 1024; idx += NGT) {
        const int i = (int)(idx & 1023), h = (int)((idx >> 10) & 3), kind = (int)((idx >> 12) & 1), l = (int)(idx >> 13);
        const float* wr = P.w_in + ((size_t)l * 1024 + i) * DIN + h * 64;
        const float* cs = (const float*)(P.ws + WS_CSW) + ((size_t)((l * 2 + kind) * 4 + h) * 64) * 64;
        float acc[64];
#pragma unroll
        for (int e = 0; e < 64; ++e) acc[e] = 0.f;
        for (int d = 0; d < 64; ++d) { const float xv = wr[d];
#pragma unroll
            for (int e = 0; e < 64; ++e) acc[e] += xv * cs[d * 64 + e]; }
        bf16* dst = (bf16*)(P.ws + WS_WPQ) + ((size_t)l * 512 + kind * 256 + h * 64) * 1024 + i;
#pragma unroll
        for (int e = 0; e < 64; ++e) dst[(size_t)e * 1024] = (bf16)f2bf(acc[e]);
    }
}

template <int MODE>
__device__ __forceinline__ void phase_rowpass1(const Ptrs& P, LAS unsigned char* lds, int layer, int tid_, int vcu, int G) {
    const int tid = otid(); (void)tid_;
    const int lane = tid & 63, wave = tid >> 6, gw = vcu * NWAVES + wave, NGW = G * NWAVES;
    LAS float* gwt = (LAS float*)lds;
    if (MODE != 2) {
        for (int idx = tid; idx < 4096; idx += NTHR) { const int k = idx >> 2, q = idx & 3; const f32x4 v = *(const f32x4*)(P.w_in + ((size_t)layer * 1024 + k) * DIN + 2304 + 4 * q);
            gwt[(4 * q + 0) * 1024 + k] = v[0]; gwt[(4 * q + 1) * 1024 + k] = v[1]; gwt[(4 * q + 2) * 1024 + k] = v[2]; gwt[(4 * q + 3) * 1024 + k] = v[3]; }
        __syncthreads();
    }
    float* H = (float*)(P.ws + WS_H); const bf16* GE = (const bf16*)(P.ws + WS_GE);
    const float* pg = P.ple_norm_g + (size_t)(layer - 1) * D;
    const float* g1 = (MODE == 2) ? P.final_g : P.norm1_g + (size_t)layer * D;
    for (int row = gw; row < T; row += NGW) {
        f32x4 v[4];
        if (MODE == 0) {
#pragma unroll
            for (int j = 0; j < 4; ++j) v[j] = ((const f32x4*)(P.x + (size_t)row * D))[lane + 64 * j];
        } else {
            f32x4 e[4]; float ss = 0.f;
#pragma unroll
            for (int j = 0; j < 4; ++j) { v[j] = ((const f32x4*)(H + (size_t)row * D))[lane + 64 * j]; const v2u w = ((const v2u*)(GE + (size_t)row * D))[lane + 64 * j];
                e[j] = (f32x4){bflo(w.x), bfhi(w.x), bflo(w.y), bfhi(w.y)}; ss += e[j][0] * e[j][0] + e[j][1] * e[j][1] + e[j][2] * e[j][2] + e[j][3] * e[j][3]; }
            const float r = rsqrtf(wave_sum(ss) * (1.f / D) + EPS);
#pragma unroll
            for (int j = 0; j < 4; ++j) { const f32x4 g = ((const f32x4*)pg)[lane + 64 * j]; v[j] = v[j] + e[j] * r * g; }
        }
        if (MODE != 2) {
#pragma unroll
            for (int j = 0; j < 4; ++j) ((f32x4*)(H + (size_t)row * D))[lane + 64 * j] = v[j];
        }
        float ss = 0.f;
#pragma unroll
        for (int j = 0; j < 4; ++j) ss += v[j][0] * v[j][0] + v[j][1] * v[j][1] + v[j][2] * v[j][2] + v[j][3] * v[j][3];
        const float rstd = rsqrtf(wave_sum(ss) * (1.f / D) + EPS);
#pragma unroll
        for (int j = 0; j < 4; ++j) { const f32x4 g = ((const f32x4*)g1)[lane + 64 * j]; v[j] = v[j] * rstd * g; }
        if (MODE == 2) {
#pragma unroll
            for (int j = 0; j < 4; ++j) ((f32x4*)(P.out + (size_t)row * D))[lane + 64 * j] = v[j];
        } else {
            bf16* A = (bf16*)(P.ws + WS_AALL) + (size_t)row * D;
#pragma unroll
            for (int j = 0; j < 4; ++j) { v2u w; w.x = pk2(v[j][0], v[j][1]); w.y = pk2(v[j][2], v[j][3]); ((v2u*)A)[lane + 64 * j] = w; }
            float mine = 0.f;
#pragma unroll 1
            for (int g = 0; g < 16; ++g) { float s = 0.f;
#pragma unroll
                for (int j = 0; j < 4; ++j) { const f32x4 w = *(const LAS f32x4*)(gwt + g * 1024 + 4 * (lane + 64 * j)); s += v[j][0] * w[0] + v[j][1] * w[1] + v[j][2] * w[2] + v[j][3] * w[3]; }
                s = wave_sum(s); mine = (lane == g) ? s : mine; }
            if (lane < 16) { float gv = mine + P.gate_b[layer * 16 + lane]; if ((lane >> 2) & 1) gv = logsigf_(gv); ((float*)(P.ws + WS_GATES))[(size_t)row * 16 + lane] = gv; }
        }
    }
}
__device__ __forceinline__ void phase_rowpass2(const Ptrs& P, int layer, int tid_, int vcu, int G) {
    const int tid = otid(); (void)tid_;
    const int lane = tid & 63, wave = tid >> 6, gw = vcu * NWAVES + wave, NGW = G * NWAVES;
    const float* H = (const float*)(P.ws + WS_H); const float* g2 = P.norm2_g + (size_t)layer * D;
    for (int row = gw; row < T; row += NGW) {
        f32x4 v[4]; float ss = 0.f;
#pragma unroll
        for (int j = 0; j < 4; ++j) { v[j] = ((const f32x4*)(H + (size_t)row * D))[lane + 64 * j]; ss += v[j][0] * v[j][0] + v[j][1] * v[j][1] + v[j][2] * v[j][2] + v[j][3] * v[j][3]; }
        const float rstd = rsqrtf(wave_sum(ss) * (1.f / D) + EPS);
        bf16* A = (bf16*)(P.ws + WS_AALL) + (size_t)row * D;
#pragma unroll
        for (int j = 0; j < 4; ++j) { const f32x4 g = ((const f32x4*)g2)[lane + 64 * j]; v2u w; w.x = pk2(v[j][0] * rstd * g[0], v[j][1] * rstd * g[1]); w.y = pk2(v[j][2] * rstd * g[2], v[j][3] * rstd * g[3]); ((v2u*)A)[lane + 64 * j] = w; }
    }
}
__device__ __forceinline__ void phase_combine(const Ptrs& P, int tid_, int vcu, int G) {
    const int tid = otid(); (void)tid_;
    const int lane = tid & 63, wave = tid >> 6, gw = vcu * NWAVES + wave, NGW = G * NWAVES;
    float* H = (float*)(P.ws + WS_H); const bf16* Y = (const bf16*)(P.ws + WS_AALL); bf16* HB = (bf16*)(P.ws + WS_HB);
    const float* tg = (const float*)(P.ws + WS_TOPK + 512 * 1024); const int* slot_of = (const int*)(P.ws + WS_TOPK + 1024 * 1024);
    for (int t = gw; t < T; t += NGW) {
        f32x4 v[4];
#pragma unroll
        for (int j = 0; j < 4; ++j) { v[j] = ((const f32x4*)(H + (size_t)t * D))[lane + 64 * j]; const v2u w = ((const v2u*)(Y + (size_t)t * D))[lane + 64 * j];
            v[j] = v[j] + (f32x4){bflo(w.x), bfhi(w.x), bflo(w.y), bfhi(w.y)}; }
        int msl = 0; float mg = 0.f;
        if (lane < 8) { msl = slot_of[(size_t)t * 8 + lane]; mg = tg[(size_t)t * 8 + lane]; }
#pragma unroll
        for (int k = 0; k < 8; ++k) { const int sl = __shfl(msl, k); const float g = __shfl(mg, k); const v2u* yr = (const v2u*)(Y + (size_t)sl * D);
#pragma unroll
            for (int j = 0; j < 4; ++j) { const v2u w = yr[lane + 64 * j]; v[j] = v[j] + (f32x4){bflo(w.x), bfhi(w.x), bflo(w.y), bfhi(w.y)} * g; } }
#pragma unroll
        for (int j = 0; j < 4; ++j) { ((f32x4*)(H + (size_t)t * D))[lane + 64 * j] = v[j]; v2u w; w.x = pk2(v[j][0], v[j][1]); w.y = pk2(v[j][2], v[j][3]); ((v2u*)(HB + (size_t)t * D))[lane + 64 * j] = w; }
    }
}

__device__ __forceinline__ void conv16(const bf16* z, const float* cw, int trow, int sg, int zcol, int wcol, float (&o)[16]) {
    const bf16* zr = z + (size_t)trow * 2048 + zcol;
    v4u c0 = *(const v4u*)zr, c1 = *(const v4u*)(zr + 8), p0 = {0u, 0u, 0u, 0u}, p1 = p0, n0 = p0, n1 = p0;
    if (sg > 0) { p0 = *(const v4u*)(zr - 2048); p1 = *(const v4u*)(zr - 2048 + 8); }
    if (sg < SEQ - 1) { n0 = *(const v4u*)(zr + 2048); n1 = *(const v4u*)(zr + 2048 + 8); }
    const unsigned pw[8] = {p0.x, p0.y, p0.z, p0.w, p1.x, p1.y, p1.z, p1.w}, cwd[8] = {c0.x, c0.y, c0.z, c0.w, c1.x, c1.y, c1.z, c1.w}, nw[8] = {n0.x, n0.y, n0.z, n0.w, n1.x, n1.y, n1.z, n1.w};
#pragma unroll
    for (int i = 0; i < 8; ++i) {
        const float w0a = cw[wcol + 2 * i], w0b = cw[wcol + 2 * i + 1], w1a = cw[512 + wcol + 2 * i], w1b = cw[512 + wcol + 2 * i + 1], w2a = cw[1024 + wcol + 2 * i], w2b = cw[1024 + wcol + 2 * i + 1];
        o[2 * i] = siluf_(w0a * bflo(pw[i]) + w1a * bflo(cwd[i]) + w2a * bflo(nw[i]));
        o[2 * i + 1] = siluf_(w0b * bfhi(pw[i]) + w1b * bfhi(cwd[i]) + w2b * bfhi(nw[i])); }
}
__device__ __forceinline__ void stage_vT(LAS unsigned char* VT, const bf16* z, int t0, int hh, int tid) {
    const int s = tid >> 2, part = tid & 3; const bf16* src = z + (size_t)(t0 + s) * 2048 + 1024 + hh * 128 + part * 32;
#pragma unroll
    for (int q = 0; q < 4; ++q) { const v4u w = *(const v4u*)(src + 8 * q); const unsigned ww[4] = {w.x, w.y, w.z, w.w};
#pragma unroll
        for (int i = 0; i < 4; ++i) { const int e = part * 32 + q * 8 + 2 * i; *(LAS bf16*)(VT + e * 272 + s * 2) = (bf16)(ww[i] & 0xffffu); *(LAS bf16*)(VT + (e + 1) * 272 + s * 2) = (bf16)(ww[i] >> 16); } }
}

__device__ __forceinline__ void m1_unit(LAS unsigned char* L, int u, const bf16* z, const float* gates, const float* cw, float* cloc, float* nloc, float* mg, int tid_) {
    const int tid = otid(); (void)tid_;
    constexpr int VT = 0, KWF = 34816, KWB = 52224, GA = 69632;
    const int lane = tid & 63, w = tid >> 6, fr = lane & 15, fq = lane >> 4;
    const int c = u & 15, hh = (u >> 4) & 3, b = u >> 6, t0 = b * SEQ + c * 128;
    LAS float* ga = (LAS float*)(L + GA);
    if (tid < 128) { const float* g = gates + (size_t)(t0 + tid) * 16; ga[tid] = g[hh]; ga[128 + tid] = g[4 + hh]; ga[256 + tid] = g[8 + hh]; ga[384 + tid] = g[12 + hh]; }
    stage_vT(L + VT, z, t0, hh, tid);
    __syncthreads();
    if (tid == 0 || tid == 64) {
        const int dir = tid >> 6; LAS float* li = ga + dir * 256; LAS float* lf = li + 128; LAS float* wo = ga + 512 + dir * 128;
        float bsum = 0.f;
        if (!dir) { for (int j = 0; j < 128; ++j) { bsum += lf[j]; lf[j] = bsum; } } else { for (int j = 127; j >= 0; --j) { bsum += lf[j]; lf[j] = bsum; } }
        const float g = bsum; float m = -3.0e38f;
        for (int j = 0; j < 128; ++j) { const float a = g - lf[j] + li[j]; wo[j] = a; m = fmaxf(m, a); }
        for (int j = 0; j < 128; ++j) wo[j] = __expf(wo[j] - m);
        mg[((size_t)dir * 512 + u) * 2 + 0] = m; mg[((size_t)dir * 512 + u) * 2 + 1] = g;
    }
    __syncthreads();
    { const int s = tid >> 2, part = tid & 3; float k[16]; conv16(z, cw, t0 + s, c * 128 + s, 768 + hh * 64 + part * 16, 256 + hh * 64 + part * 16, k);
      const float wF = ga[512 + s], wB = ga[640 + s];
#pragma unroll
      for (int i = 0; i < 16; ++i) { const int d = part * 16 + i; *(LAS bf16*)(L + KWF + d * 272 + s * 2) = (bf16)f2bf(wF * k[i]); *(LAS bf16*)(L + KWB + d * 272 + s * 2) = (bf16)f2bf(wB * k[i]); } }
    __syncthreads();
    { const int dir = w >> 2, wq = w & 3; LAS unsigned char* KW = L + (dir ? KWB : KWF);
      f32x4 acc[2][4];
#pragma unroll
      for (int mt = 0; mt < 2; ++mt)
#pragma unroll
          for (int nt = 0; nt < 4; ++nt) acc[mt][nt] = (f32x4){0.f, 0.f, 0.f, 0.f};
#pragma unroll
      for (int ks = 0; ks < 4; ++ks) { bf16x8 a[2];
#pragma unroll
          for (int mt = 0; mt < 2; ++mt) a[mt] = *(const LAS bf16x8*)(L + VT + (32 * wq + mt * 16 + fr) * 272 + ks * 64 + fq * 16);
#pragma unroll
          for (int nt = 0; nt < 4; ++nt) { const bf16x8 bk = *(const LAS bf16x8*)(KW + (nt * 16 + fr) * 272 + ks * 64 + fq * 16);
#pragma unroll
              for (int mt = 0; mt < 2; ++mt) acc[mt][nt] = MFMA16(a[mt], bk, acc[mt][nt]); } }
      float* co = cloc + ((size_t)dir * 512 + u) * 8192;
#pragma unroll
      for (int mt = 0; mt < 2; ++mt)
#pragma unroll
          for (int nt = 0; nt < 4; ++nt)
#pragma unroll
              for (int r = 0; r < 4; ++r) co[(32 * wq + mt * 16 + 4 * fq + r) * 64 + nt * 16 + fr] = acc[mt][nt][r]; }
    if (tid < 128) { const int dir = tid >> 6, d = tid & 63; const LAS unsigned char* KW = L + (dir ? KWB : KWF) + d * 272; float s = 0.f;
        for (int q = 0; q < 16; ++q) { const v4u w4 = *(const LAS v4u*)(KW + q * 16); s += bflo(w4.x) + bfhi(w4.x) + bflo(w4.y) + bfhi(w4.y) + bflo(w4.z) + bfhi(w4.z) + bflo(w4.w) + bfhi(w4.w); }
        nloc[((size_t)dir * 512 + u) * 64 + d] = s; }
    __syncthreads();
}

__device__ __forceinline__ void phase_m2(const Ptrs& P, int tid_, int vcu, int G) {
    const int tid = otid(); (void)tid_;
    const float* cloc = (const float*)(P.ws + WS_CLOC); bf16* cprev = (bf16*)(P.ws + WS_CPREV);
    float* sm = (float*)(P.ws + WS_SMALL); const float* nloc = sm; float* nprev = sm + 65536; const float* mg = sm + 131072; float* mprev = sm + 131072 + 2048;
    for (int it = vcu; it < 64 * 17; it += G) {
        const int seq = it / 17, blk = it % 17, dir = seq >> 5, bh = seq & 31;
        float m = 0.f, st = 0.f;
        for (int step = 0; step < 16; ++step) {
            const int c = dir ? 15 - step : step; const size_t du = (size_t)dir * 512 + bh * 16 + c;
            const float ml = mg[du * 2], g = mg[du * 2 + 1]; float loc = 0.f;
            if (blk < 16) { const int idx = blk * 512 + tid; loc = cloc[du * 8192 + idx]; cprev[du * 8192 + idx] = (bf16)f2bf(st); }
            else if (tid < 64) { loc = nloc[du * 64 + tid]; nprev[du * 64 + tid] = st; if (tid == 0) mprev[du] = m; }
            const float mn = fmaxf(g + m, ml), ao = __expf(g + m - mn), an = __expf(ml - mn);
            st = ao * st + an * loc; m = mn;
        }
    }
}

__device__ __forceinline__ void m3_unit(LAS unsigned char* L, int u, const bf16* z, const float* gates, const float* cw, const bf16* cprev, const float* nprev, const float* mprev, const float* normg, bf16* mix, int tid_) {
    const int tid = otid(); (void)tid_;
    constexpr int QS = 0, KS = 18432, VT = 36864, SM = 71680, GA = 106496;
    const int lane = tid & 63, w = tid >> 6, fr = lane & 15, fq = lane >> 4;
    const int c = u & 15, hh = (u >> 4) & 3, b = u >> 6, t0 = b * SEQ + c * 128;
    LAS float* ga = (LAS float*)(L + GA);
    if (tid < 128) { const float* g = gates + (size_t)(t0 + tid) * 16; ga[tid] = g[hh]; ga[128 + tid] = g[4 + hh]; ga[384 + tid] = g[8 + hh]; ga[512 + tid] = g[12 + hh]; }
    { const int s = tid >> 2, part = tid & 3; float o[16];
      conv16(z, cw, t0 + s, c * 128 + s, 512 + hh * 64 + part * 16, hh * 64 + part * 16, o);
      v4u w0, w1; w0.x = pk2(o[0] * 0.125f, o[1] * 0.125f); w0.y = pk2(o[2] * 0.125f, o[3] * 0.125f); w0.z = pk2(o[4] * 0.125f, o[5] * 0.125f); w0.w = pk2(o[6] * 0.125f, o[7] * 0.125f);
      w1.x = pk2(o[8] * 0.125f, o[9] * 0.125f); w1.y = pk2(o[10] * 0.125f, o[11] * 0.125f); w1.z = pk2(o[12] * 0.125f, o[13] * 0.125f); w1.w = pk2(o[14] * 0.125f, o[15] * 0.125f);
      *(LAS v4u*)(L + QS + s * 144 + part * 32) = w0; *(LAS v4u*)(L + QS + s * 144 + part * 32 + 16) = w1;
      conv16(z, cw, t0 + s, c * 128 + s, 768 + hh * 64 + part * 16, 256 + hh * 64 + part * 16, o);
      w0.x = pk2(o[0], o[1]); w0.y = pk2(o[2], o[3]); w0.z = pk2(o[4], o[5]); w0.w = pk2(o[6], o[7]); w1.x = pk2(o[8], o[9]); w1.y = pk2(o[10], o[11]); w1.z = pk2(o[12], o[13]); w1.w = pk2(o[14], o[15]);
      *(LAS v4u*)(L + KS + s * 144 + part * 32) = w0; *(LAS v4u*)(L + KS + s * 144 + part * 32 + 16) = w1; }
    stage_vT(L + VT, z, t0, hh, tid);
    __syncthreads();
    if (tid == 0) { LAS float* li = ga; LAS float* lf = ga + 128; LAS float* pm = ga + 256; float bs = 0.f, mx = -3.0e38f;
        for (int j = 0; j < 128; ++j) { bs += lf[j]; lf[j] = bs; mx = fmaxf(mx, li[j] - bs); pm[j] = mx; } }
    if (tid == 64) { LAS float* li = ga + 384; LAS float* lf = ga + 512; LAS float* pm = ga + 640; float bs = 0.f, mx = -3.0e38f;
        for (int j = 127; j >= 0; --j) { bs += lf[j]; lf[j] = bs; mx = fmaxf(mx, li[j] - bs); pm[j] = mx; } }
    __syncthreads();
    f32x4 S[8]; bf16x8 aq[2];
#pragma unroll
    for (int ks = 0; ks < 2; ++ks) aq[ks] = *(const LAS bf16x8*)(L + QS + (16 * w + fr) * 144 + ks * 64 + fq * 16);
#pragma unroll
    for (int nt = 0; nt < 8; ++nt) { f32x4 a = {0.f, 0.f, 0.f, 0.f};
#pragma unroll
        for (int ks = 0; ks < 2; ++ks) { const bf16x8 bk = *(const LAS bf16x8*)(L + KS + (nt * 16 + fr) * 144 + ks * 64 + fq * 16); a = MFMA16(aq[ks], bk, a); }
        S[nt] = a; }
    f32x4 hsum[8];
#pragma unroll
    for (int nt = 0; nt < 8; ++nt) hsum[nt] = (f32x4){0.f, 0.f, 0.f, 0.f};
#pragma unroll 1
    for (int dir = 0; dir < 2; ++dir) {
        const LAS float* li = ga + dir * 384; const LAS float* bb = li + 128; const LAS float* pm = li + 256;
        const size_t du = (size_t)dir * 512 + u; const float mp = mprev[du];
        float bj[4], mt[4], inter[4], rs[4];
#pragma unroll
        for (int r = 0; r < 4; ++r) { const int j = 16 * w + 4 * fq + r; bj[r] = bb[j]; mt[r] = fmaxf(bj[r] + pm[j], bj[r] + mp); inter[r] = __expf(bj[r] + mp - mt[r]); rs[r] = 0.f; }
#pragma unroll
        for (int nt = 0; nt < 8; ++nt) { const int s = nt * 16 + fr; const float xs = li[s] - bb[s];
#pragma unroll
            for (int r = 0; r < 4; ++r) { const int j = 16 * w + 4 * fq + r; const bool valid = dir ? (s >= j) : (s <= j);
                const float pv = valid ? __expf(bj[r] + xs - mt[r]) * S[nt][r] : 0.f; rs[r] += pv; *(LAS bf16*)(L + SM + j * 272 + s * 2) = (bf16)f2bf(pv); } }
#pragma unroll
        for (int r = 0; r < 4; ++r) { rs[r] += __shfl_xor(rs[r], 1); rs[r] += __shfl_xor(rs[r], 2); rs[r] += __shfl_xor(rs[r], 4); rs[r] += __shfl_xor(rs[r], 8); }
        LDS_FENCE();
        f32x4 acc[8];
#pragma unroll
        for (int nt = 0; nt < 8; ++nt) { f32x4 a = {0.f, 0.f, 0.f, 0.f};
#pragma unroll
            for (int ks = 0; ks < 2; ++ks) { const bf16x8 bc = *(const bf16x8*)(cprev + (du * 128 + nt * 16 + fr) * 64 + ks * 32 + fq * 8); a = MFMA16(aq[ks], bc, a); }
#pragma unroll
            for (int r = 0; r < 4; ++r) a[r] *= inter[r];
            acc[nt] = a; }
#pragma unroll
        for (int ks = 0; ks < 4; ++ks) { const bf16x8 ap = *(const LAS bf16x8*)(L + SM + (16 * w + fr) * 272 + ks * 64 + fq * 16);
#pragma unroll
            for (int nt = 0; nt < 8; ++nt) { const bf16x8 bv = *(const LAS bf16x8*)(L + VT + (nt * 16 + fr) * 272 + ks * 64 + fq * 16); acc[nt] = MFMA16(ap, bv, acc[nt]); } }
        float inv[4];
        { const f32x4 np = *(const f32x4*)(nprev + du * 64 + fr * 4);
#pragma unroll
          for (int r = 0; r < 4; ++r) { const int j = 16 * w + 4 * fq + r; const v2u qw = *(const LAS v2u*)(L + QS + j * 144 + fr * 8);
              float qn = bflo(qw.x) * np[0] + bfhi(qw.x) * np[1] + bflo(qw.y) * np[2] + bfhi(qw.y) * np[3];
              qn += __shfl_xor(qn, 1); qn += __shfl_xor(qn, 2); qn += __shfl_xor(qn, 4); qn += __shfl_xor(qn, 8);
              const float den = rs[r] + inter[r] * qn; inv[r] = 1.f / fmaxf(fabsf(den), __expf(-mt[r])); } }
#pragma unroll
        for (int nt = 0; nt < 8; ++nt)
#pragma unroll
            for (int r = 0; r < 4; ++r) hsum[nt][r] += acc[nt][r] * inv[r];
        LDS_FENCE();
    }
#pragma unroll
    for (int r = 0; r < 4; ++r) { const int j = 16 * w + 4 * fq + r; const size_t t = (size_t)(t0 + j); float xv[8]; float s1 = 0.f;
#pragma unroll
        for (int nt = 0; nt < 8; ++nt) { const int e = nt * 16 + fr; const float zo = bf2f(z[t * 2048 + 1536 + hh * 128 + e]); xv[nt] = sigmoidf_(zo) * hsum[nt][r]; s1 += xv[nt]; }
        s1 += __shfl_xor(s1, 1); s1 += __shfl_xor(s1, 2); s1 += __shfl_xor(s1, 4); s1 += __shfl_xor(s1, 8);
        const float mean = s1 * (1.f / 128.f); float s2 = 0.f;
#pragma unroll
        for (int nt = 0; nt < 8; ++nt) { xv[nt] -= mean; s2 += xv[nt] * xv[nt]; }
        s2 += __shfl_xor(s2, 1); s2 += __shfl_xor(s2, 2); s2 += __shfl_xor(s2, 4); s2 += __shfl_xor(s2, 8);
        const float rstd = rsqrtf(s2 * (1.f / 128.f) + EPS);
#pragma unroll
        for (int nt = 0; nt < 8; ++nt) { const int e = nt * 16 + fr; mix[t * 1024 + 512 + hh * 128 + e] = (bf16)f2bf(xv[nt] * rstd * normg[hh * 128 + e]); } }
    __syncthreads();
}

__device__ __forceinline__ void gmlp_unit(LAS unsigned char* L, int u, const bf16* z, const bf16* wsb, const float* bs, const float* lng, const float* lnb, bf16* mix, int tid_) {
    const int tid = otid(); (void)tid_;
    const int lane = tid & 63, w = tid >> 6, fr = lane & 15, fq = lane >> 4, t0 = u * 128;
    { const int j = tid >> 2, part = tid & 3; const bf16* src = z + (size_t)(t0 + j) * 2048 + 256 + part * 64; float x[64]; float s1 = 0.f;
#pragma unroll
      for (int q = 0; q < 8; ++q) { const v4u w4 = *(const v4u*)(src + 8 * q); const unsigned ww[4] = {w4.x, w4.y, w4.z, w4.w};
#pragma unroll
          for (int i = 0; i < 4; ++i) { x[q * 8 + 2 * i] = geluf_(bflo(ww[i])); x[q * 8 + 2 * i + 1] = geluf_(bfhi(ww[i])); s1 += x[q * 8 + 2 * i] + x[q * 8 + 2 * i + 1]; } }
      s1 += __shfl_xor(s1, 1); s1 += __shfl_xor(s1, 2); const float mean = s1 * (1.f / 256.f); float s2 = 0.f;
#pragma unroll
      for (int i = 0; i < 64; ++i) { x[i] -= mean; s2 += x[i] * x[i]; }
      s2 += __shfl_xor(s2, 1); s2 += __shfl_xor(s2, 2); const float rstd = rsqrtf(s2 * (1.f / 256.f) + EPS);
#pragma unroll
      for (int i = 0; i < 64; ++i) { const int col = part * 64 + i; *(LAS bf16*)(L + col * 272 + j * 2) = (bf16)f2bf(x[i] * rstd * lng[col] + lnb[col]); } }
    __syncthreads();
#pragma unroll 1
    for (int hh = 0; hh < 4; ++hh) { f32x4 acc[4];
#pragma unroll
        for (int nt = 0; nt < 4; ++nt) acc[nt] = (f32x4){0.f, 0.f, 0.f, 0.f};
#pragma unroll
        for (int ks = 0; ks < 4; ++ks) { const bf16x8 a = *(const bf16x8*)(wsb + ((size_t)(hh * 128 + 16 * w + fr) * 128 + ks * 32 + fq * 8));
#pragma unroll
            for (int nt = 0; nt < 4; ++nt) { const bf16x8 bv = *(const LAS bf16x8*)(L + (hh * 64 + nt * 16 + fr) * 272 + ks * 64 + fq * 16); acc[nt] = MFMA16(a, bv, acc[nt]); } }
#pragma unroll
        for (int nt = 0; nt < 4; ++nt)
#pragma unroll
            for (int r = 0; r < 4; ++r) { const int i = 16 * w + 4 * fq + r, d = nt * 16 + fr; const float sv = acc[nt][r] + bs[hh * 128 + i];
                const float uu = geluf_(bf2f(z[(size_t)(t0 + i) * 2048 + hh * 64 + d])); mix[(size_t)(t0 + i) * 1024 + 256 + hh * 64 + d] = (bf16)f2bf(uu * sv); } }
    __syncthreads();
}

__device__ __forceinline__ void phase_topk(const Ptrs& P, LAS unsigned char* lds, int layer, int tid_, int vcu, int G) {
    const int tid = otid(); (void)tid_;
    const int lane = tid & 63, wave = tid >> 6, gw = vcu * NWAVES + wave, NGW = G * NWAVES;
    LAS int* hist = (LAS int*)lds;
    if (tid < 128) hist[tid] = 0;
    __syncthreads();
    const float* lg = (const float*)(P.ws + WS_LOGIT); const float* rb = P.router_b + layer * NE;
    int* te = (int*)(P.ws + WS_TOPK); float* tg = (float*)(P.ws + WS_TOPK + 512 * 1024);
    const float rb0 = rb[lane], rb1 = rb[64 + lane];
    for (int t = gw; t < T; t += NGW) {
        const float s0 = sigmoidf_(lg[(size_t)t * 128 + lane]), s1 = sigmoidf_(lg[(size_t)t * 128 + 64 + lane]);
        float v0 = s0 + rb0, v1 = s1 + rb1; float mys = 0.f, sum = 0.f; int mye = 0;
#pragma unroll 1
        for (int k = 0; k < 8; ++k) {
            float bv; int bi; if (v0 >= v1) { bv = v0; bi = lane; } else { bv = v1; bi = lane + 64; }
#pragma unroll
            for (int off = 32; off >= 1; off >>= 1) { const float ov = __shfl_xor(bv, off); const int oi = __shfl_xor(bi, off); if (ov > bv || (ov == bv && oi < bi)) { bv = ov; bi = oi; } }
            const float wsc = __shfl((bi < 64) ? s0 : s1, bi & 63);
            if (lane == k) { mye = bi; mys = wsc; }
            sum += wsc;
            if (lane == (bi & 63)) { if (bi < 64) v0 = -3.0e38f; else v1 = -3.0e38f; }
        }
        if (lane < 8) { te[(size_t)t * 8 + lane] = mye; tg[(size_t)t * 8 + lane] = mys / sum; __hip_atomic_fetch_add(hist + mye, 1, __ATOMIC_RELAXED, __HIP_MEMORY_SCOPE_WORKGROUP); }
    }
    __syncthreads();
    if (tid < 128) { const int hc = hist[tid]; if (hc) __hip_atomic_fetch_add((unsigned*)(P.ws + WS_CTL) + CW_CNT + layer * 256 + tid, (unsigned)hc, __ATOMIC_RELAXED, __HIP_MEMORY_SCOPE_AGENT); }
    __syncthreads();
}
__device__ __forceinline__ void compute_blkoff(const Ptrs& P, LAS int* tbl, int layer, int tid_) {
    const int tid = otid(); (void)tid_;
    __syncthreads();
    if (tid == 0) { const unsigned* cnt = (const unsigned*)(P.ws + WS_CTL) + CW_CNT + layer * 256; int o = 0;
        for (int e = 0; e < 128; ++e) { tbl[e] = o; o += (int)((__hip_atomic_load(cnt + e, __ATOMIC_RELAXED, __HIP_MEMORY_SCOPE_AGENT) + 255u) >> 8); } tbl[128] = o; }
    __syncthreads();
}
__device__ __forceinline__ void phase_assign(const Ptrs& P, LAS unsigned char* lds, LAS int* blkoff, int layer, int tid_, int vcu, int G) {
    const int tid = otid(); (void)tid_;
    const int lane = tid & 63, wave = tid >> 6;
    LAS int* hist = (LAS int*)lds; LAS int* base = hist + 128; LAS int* slots = hist + 256;
    const int* te = (const int*)(P.ws + WS_TOPK); int* slot_of = (int*)(P.ws + WS_TOPK + 1024 * 1024);
    unsigned* cursor = (unsigned*)(P.ws + WS_CTL) + CW_CNT + layer * 256 + 128;
    bf16* A = (bf16*)(P.ws + WS_AALL);
    for (int tb = vcu; tb < T / 64; tb += G) {
        if (tid < 128) hist[tid] = 0;
        __syncthreads();
        const int p = tb * 512 + tid, e = te[p];
        const int rank = __hip_atomic_fetch_add(hist + e, 1, __ATOMIC_RELAXED, __HIP_MEMORY_SCOPE_WORKGROUP);
        __syncthreads();
        if (tid < 128) { const int hc = hist[tid]; base[tid] = hc ? (int)__hip_atomic_fetch_add(cursor + tid, (unsigned)hc, __ATOMIC_RELAXED, __HIP_MEMORY_SCOPE_AGENT) : 0; }
        __syncthreads();
        const int slot = T + blkoff[e] * 256 + base[e] + rank;
        slot_of[p] = slot; slots[tid] = slot;
        __syncthreads();
        for (int i = 0; i < 64; ++i) { const int pp = wave * 64 + i, sl = slots[pp], tok = (tb * 512 + pp) >> 3;
            const v4u* src = (const v4u*)(A + (size_t)tok * D); v4u* dst = (v4u*)(A + (size_t)sl * D);
            const v4u a = src[lane], b2 = src[lane + 64]; dst[lane] = a; dst[lane + 64] = b2; }
        __syncthreads();
    }
}

struct Args { const float* in[26]; float* out; unsigned char* ws; int ph_lo, ph_hi, li, pad; };
constexpr int N_PHASES = 2 + NL * 14 + 1;

__global__ void __launch_bounds__(NTHR, 2) mk_fwd(Args args) {
    extern __shared__ __attribute__((aligned(16))) unsigned char lds_raw[];
    LAS unsigned char* lds = (LAS unsigned char*)lds_raw;
    const int G = gridDim.x;
    const int vcu = (G % 8 == 0) ? ((int)blockIdx.x % 8) * (G / 8) + (int)blockIdx.x / 8 : (int)blockIdx.x;
    volatile LAS unsigned* MISC = (volatile LAS unsigned*)(lds + LDS_MISC);
    LAS int* blkoff = (LAS int*)(lds + LDS_TBL);
    if (threadIdx.x < 4) MISC[threadIdx.x] = 0u;
    __syncthreads();
    XcdBarrier bar; bar.bar = (unsigned*)(args.ws + WS_CTL) + CW_BAR + args.li * XCD_BAR_WORDS; bar.x = 0; bar.st = nullptr;
#if !MK_SPLIT
    bar = xcd_barrier_post((unsigned*)(args.ws + WS_CTL) + CW_BAR + args.li * XCD_BAR_WORDS, MISC);
#endif
    const int lo = args.ph_lo, hi = args.ph_hi;
#define IN(k) (lo <= (k) && (k) < hi)
#if MK_SPLIT
#define SEAM(k) do { } while (0)
#else
#define SEAM(k) do { if ((k) + 1 < hi) xcd_barrier(bar); } while (0)
#endif
#define PTRS() Ptrs P; load_ptrs(P); unsigned char* const ws = P.ws; (void)ws

    if (EN(0) && IN(0)) { PTRS(); phase_p0a(P, lds, 0, vcu, G); SEAM(0); }
    if (EN(1) && IN(1)) {
        PTRS();
        phase_p0b_fold(P, 0, vcu, G);
        { pg8::Gemm g{(const bf16*)(ws + WS_PB), (const bf16*)(ws + WS_PLEIN), NL * T, NL * 1024, 256}; StackOrder S{NL, 64, 4, G, (int)blockIdx.x};
          EpiStoreBf16 E{(bf16*)(ws + WS_E), 1024, 3}; pg8::gemm_phase<EpiStoreBf16, StackOrder>(lds, g, S, E, nullptr); }
        SEAM(1);
    }
#pragma unroll 1
    for (int layer = 0; layer < NL; ++layer) {
        const int k0 = 2 + layer * 14;
        if (EN(2) && IN(k0 + 0)) { PTRS(); if (layer == 0) phase_rowpass1<0>(P, lds, layer, 0, vcu, G); else phase_rowpass1<1>(P, lds, layer, 0, vcu, G); SEAM(k0 + 0); }
        if (EN(3) && IN(k0 + 1)) {
            PTRS();
            { pg8::Gemm g{(const bf16*)(ws + WS_AALL), (const bf16*)(ws + WS_WIN) + (size_t)layer * 2048 * 1024, T, 2048, 1024}; pg8::StaticOrder S; S.init(T, 2048, G, (int)blockIdx.x);
              EpiStoreBf16 E{(bf16*)(ws + WS_Z), 2048, 0xffff}; pg8::gemm_phase<EpiStoreBf16, pg8::StaticOrder>(lds, g, S, E, nullptr); }
            { pg8::Gemm g{(const bf16*)(ws + WS_WPQ) + (size_t)layer * 512 * 1024, (const bf16*)(ws + WS_AALL), 512, T, 1024}; pg8::StaticOrder S; S.init(512, T, G, (int)blockIdx.x);
              EpiPQ E{(bf16*)(ws + WS_PQT)}; pg8::gemm_phase<EpiPQ, pg8::StaticOrder>(lds, g, S, E, nullptr); }
            SEAM(k0 + 1);
        }
        if (EN(4) && IN(k0 + 2)) {
            const int nf = (G >= 128) ? 64 : 0;
            if ((L3MASK & 1) && ((int)blockIdx.x < 64 || nf == 0)) {
                PTRS();
                pg8::Gemm g{(const bf16*)(ws + WS_DFT), (const bf16*)(ws + WS_PQT), 2048, 2048, 4096}; pg8::StaticOrder S; S.init(2048, 2048, nf ? 64 : G, (int)blockIdx.x);
                EpiFourier E{(bf16*)(ws + WS_MIX)}; pg8::gemm_phase<EpiFourier, pg8::StaticOrder>(lds, g, S, E, nullptr);
            }
            if ((int)blockIdx.x >= nf) {
                PTRS();
                const int c2 = (int)blockIdx.x - nf, G2 = G - nf;
                for (int it = c2; it < 128 + 512; it += G2) {
                    if (it < 128) { if (L3MASK & 2) gmlp_unit(lds, it, (const bf16*)(ws + WS_Z), (const bf16*)(ws + WS_GWS) + (size_t)layer * 4 * 128 * 128, P.gmlp_bs + (size_t)layer * 512, P.gmlp_ln_g + (size_t)layer * 256, P.gmlp_ln_b + (size_t)layer * 256, (bf16*)(ws + WS_MIX), 0); }
                    else if (L3MASK & 4) m1_unit(lds, it - 128, (const bf16*)(ws + WS_Z), (const float*)(ws + WS_GATES), P.conv_w + (size_t)layer * 3 * 512, (float*)(ws + WS_CLOC), (float*)(ws + WS_SMALL), (float*)(ws + WS_SMALL) + 131072, 0);
                }
            }
            SEAM(k0 + 2);
        }
        if (EN(5) && IN(k0 + 3)) { PTRS(); phase_m2(P, 0, vcu, G); SEAM(k0 + 3); }
        if (EN(6) && IN(k0 + 4)) {
            PTRS();
            for (int u = (int)blockIdx.x; u < 512; u += G) m3_unit(lds, u, (const bf16*)(ws + WS_Z), (const float*)(ws + WS_GATES), P.conv_w + (size_t)layer * 3 * 512, (const bf16*)(ws + WS_CPREV), (const float*)(ws + WS_SMALL) + 65536, (const float*)(ws + WS_SMALL) + 131072 + 2048, P.mnorm_g + (size_t)layer * 512, (bf16*)(ws + WS_MIX), 0);
            SEAM(k0 + 4);
        }
        if (EN(7) && IN(k0 + 5)) {
            PTRS();
            pg8::Gemm g{(const bf16*)(ws + WS_MIX), (const bf16*)(ws + WS_WOUT) + (size_t)layer * 1024 * 1024, T, 1024, 1024}; pg8::StaticOrder S; S.init(T, 1024, G, (int)blockIdx.x);
            EpiResid E{(float*)(ws + WS_H)}; pg8::gemm_phase<EpiResid, pg8::StaticOrder>(lds, g, S, E, nullptr);
            SEAM(k0 + 5);
        }
        if (EN(8) && IN(k0 + 6)) { PTRS(); phase_rowpass2(P, layer, 0, vcu, G); SEAM(k0 + 6); }
        if (EN(9) && IN(k0 + 7)) {
            PTRS();
            pg8::Gemm g{(const bf16*)(ws + WS_AALL), (const bf16*)(ws + WS_ROUT) + (size_t)layer * 256 * 1024, T, 256, 1024}; pg8::StaticOrder S; S.init(T, 256, G, (int)blockIdx.x);
            EpiLogits E{(float*)(ws + WS_LOGIT)}; pg8::gemm_phase<EpiLogits, pg8::StaticOrder>(lds, g, S, E, nullptr);
            SEAM(k0 + 7);
        }
        if (EN(10) && IN(k0 + 8)) { PTRS(); phase_topk(P, lds, layer, 0, vcu, G); SEAM(k0 + 8); }
        if (EN(11) && IN(k0 + 9)) { PTRS(); compute_blkoff(P, blkoff, layer, 0); phase_assign(P, lds, blkoff, layer, 0, vcu, G); SEAM(k0 + 9); }
        if (EN(12) && IN(k0 + 10)) {
            PTRS();
            compute_blkoff(P, blkoff, layer, 0);
            pg8::Gemm g{(const bf16*)(ws + WS_AALL), (const bf16*)(ws + WS_WGU + (size_t)layer * WGU_L), AALL_ROWS, 129 * 512, 1024};
            MoeOrder S{blkoff, 2, G, (int)blockIdx.x, (64 + __builtin_amdgcn_readfirstlane(blkoff[128])) * 2};
            EpiSwiglu E{(bf16*)(ws + WS_ACT)}; pg8::gemm_phase<EpiSwiglu, MoeOrder>(lds, g, S, E, nullptr);
            SEAM(k0 + 10);
        }
        if (EN(13) && IN(k0 + 11)) {
            PTRS();
            compute_blkoff(P, blkoff, layer, 0);
            pg8::Gemm g{(const bf16*)(ws + WS_ACT), (const bf16*)(ws + WS_WD + (size_t)layer * WD_L), AALL_ROWS, 129 * 1024, 256};
            MoeOrder S{blkoff, 4, G, (int)blockIdx.x, (64 + __builtin_amdgcn_readfirstlane(blkoff[128])) * 4};
            EpiStoreBf16 E{(bf16*)(ws + WS_AALL), 1024, 3}; pg8::gemm_phase<EpiStoreBf16, MoeOrder>(lds, g, S, E, nullptr);
            SEAM(k0 + 11);
        }
        if (EN(14) && IN(k0 + 12)) { PTRS(); phase_combine(P, 0, vcu, G); SEAM(k0 + 12); }
        if (EN(15) && IN(k0 + 13)) {
            PTRS();
            pg8::Gemm g{(const bf16*)(ws + WS_HB), (const bf16*)(ws + WS_PLEG) + (size_t)layer * 1024 * 1024, T, 1024, 1024}; pg8::StaticOrder S; S.init(T, 1024, G, (int)blockIdx.x);
            EpiPleGate E{(bf16*)(ws + WS_GE), (const bf16*)(ws + WS_E) + (size_t)layer * T * 1024}; pg8::gemm_phase<EpiPleGate, pg8::StaticOrder>(lds, g, S, E, nullptr);
            SEAM(k0 + 13);
        }
    }
    if (EN(16) && IN(N_PHASES - 1)) { PTRS(); phase_rowpass1<2>(P, lds, NL, 0, vcu, G); }
#undef IN
#undef SEAM
#undef PTRS
}

extern "C" void kernel_launch(void* const* d_in, const int* in_sizes, int n_in, void* d_out, int out_size, void* d_ws, size_t ws_size, hipStream_t stream) {
    static int grid = 0;
    if (grid == 0) {
        if (n_in != 26 || ws_size < WS_END) { fprintf(stderr, "kernel_launch: need 26 inputs and %zu bytes of workspace (got %d, %zu)\n", (size_t)WS_END, n_in, ws_size); grid = -1; return; }
        int dev = 0, cus = 0, per_cu = 0;
        if (hipGetDevice(&dev) != hipSuccess || hipDeviceGetAttribute(&cus, hipDeviceAttributeMultiprocessorCount, dev) != hipSuccess) { grid = -1; return; }
        if (hipFuncSetAttribute((const void*)mk_fwd, hipFuncAttributeMaxDynamicSharedMemorySize, LDS_BYTES) != hipSuccess) { fprintf(stderr, "kernel_launch: hipFuncSetAttribute failed\n"); grid = -1; return; }
        if (hipOccupancyMaxActiveBlocksPerMultiprocessor(&per_cu, (const void*)mk_fwd, NTHR, LDS_BYTES) != hipSuccess || per_cu < 1) fprintf(stderr, "kernel_launch: occupancy query says %d\n", per_cu);
        (void)hipGetLastError();
        grid = cus;
    }
    if (grid < 0) return;
    (void)hipMemsetAsync((char*)d_ws + WS_CTL, 0, CTL_BYTES, stream);
    Args a{};
    for (int i = 0; i < 26; ++i) a.in[i] = (const float*)d_in[i];
    a.out = (float*)d_out; a.ws = (unsigned char*)d_ws; a.pad = 0;
#if MK_SPLIT
    for (int ph = 0; ph < N_PHASES; ++ph) { a.ph_lo = ph; a.ph_hi = ph + 1; a.li = 0; hipLaunchKernelGGL(mk_fwd, dim3(grid), dim3(NTHR), LDS_BYTES, stream, a); }
#else
    a.ph_lo = 0; a.ph_hi = N_PHASES; a.li = 0;
    hipLaunchKernelGGL(mk_fwd, dim3(grid), dim3(NTHR), LDS_BYTES, stream, a);
#endif
    const hipError_t le = hipPeekAtLastError();
    if (le != hipSuccess) fprintf(stderr, "kernel_launch: launch failed: %s\n", hipGetErrorName(le));
}
```

```cpp
#include <hip/hip_runtime.h>
#include <cstdio>
namespace pg8 {
#define PG8_LAS __attribute__((address_space(3)))
typedef unsigned short bf16_t;
typedef short bf16x8 __attribute__((ext_vector_type(8)));
typedef float f32x4 __attribute__((ext_vector_type(4)));
typedef unsigned u32x4 __attribute__((ext_vector_type(4)));
constexpr int BM = 256, BK = 64, HALF = 128, HTB = HALF * BK * 2  , STAGE_BYTES = 8 * HTB, NXCD = 8, WGM = 8;

__host__ __device__ __forceinline__ int lds_byte(int r, int c) { const int st = (r >> 4) * 2 + (c >> 5), rr = r & 15, cc = c & 31, ob = rr * 64 + cc * 2; return st * 1024 + (ob ^ (((ob >> 9) & 1) << 5)); }
__host__ __device__ __forceinline__ void stage_rc(int b, int& R, int& C) { const int st = b / 1024, sb = b % 1024, swz = sb ^ (((sb >> 9) & 1) << 5); R = (st >> 1) * 16 + swz / 64; C = (st & 1) * 32 + (swz % 64) / 2; }
__host__ __device__ __forceinline__ int perm32(int rho) { const int n = rho >> 4, i = rho & 15; return 8 * (i >> 2) + 4 * n + (i & 3); }

struct Unit { int pm, pn, aux0, aux1; };
struct Gemm { const bf16_t* A; const bf16_t* Bt; int M, N, K; };

struct StaticOrder {
    static constexpr bool GATHER = false;
    int nM, nN, nwg, G, c;
    __host__ __device__ void init(int M, int N, int G_, int c_) { nM = M / BM; nN = N / BM; nwg = nM * nN; G = G_; c = c_; }
    __host__ __device__ bool next(int i, Unit& u) const {
        const long L = (long)i * G + c; if (L >= nwg) return false;
        int wgid = (int)L; { const int q = nwg / NXCD, r = nwg % NXCD, xcd = wgid % NXCD, off = wgid / NXCD; wgid = (xcd < r ? xcd * (q + 1) : r * (q + 1) + (xcd - r) * q) + off; }
        const int nig = WGM * nN, gid = wgid / nig, fm = gid * WGM, gsz = (nM - fm) < WGM ? (nM - fm) : WGM;
        u.pm = fm + ((wgid % nig) % gsz); u.pn = (wgid % nig) / gsz; return true;
    }
    __device__ __forceinline__ void a_ready(const Unit&) const {}
    __device__ __forceinline__ void done(const Unit&) const {}
};
__device__ __forceinline__ unsigned cvt_pk_bf16(float lo, float hi) { unsigned r; asm volatile("v_cvt_pk_bf16_f32 %0, %1, %2" : "=v"(r) : "v"(lo), "v"(hi)); return r; }
template <class Epi, class Sched, bool ALIGN_EPI = false, bool SP2 = false, bool FP8 = false>
__device__ __forceinline__ void gemm_phase(PG8_LAS unsigned char* lds, const Gemm g, const Sched& S, const Epi& E) {
    int tid_o = threadIdx.x; asm volatile("" : "+v"(tid_o));
    const int tid = tid_o, wid = __builtin_amdgcn_readfirstlane(tid >> 6), lane = tid & 63, wr = wid >> 2, wc = wid & 3, fr = lane & 15, fq = lane >> 4;
    const int K = g.K, nt = FP8 ? K / (2 * BK) : K / BK;
    const int mx_one = 0x7f7f7f7f;
    unsigned voffA[2], voffB[2]; int RA[2]; unsigned CA[2];
#pragma unroll
    for (int i = 0; i < 2; ++i) { int R, C; stage_rc(tid * 16 + i * 8192, R, C); const int Rb = Epi::PERM ? ((R & ~31) + perm32(R & 31)) : R;
        voffA[i] = FP8 ? (unsigned)(R * K + C * 2) : (unsigned)(R * K + C) * 2u; voffB[i] = FP8 ? (unsigned)(Rb * K + C * 2) : (unsigned)(Rb * K + C) * 2u; RA[i] = R; CA[i] = (unsigned)C * 2u; }
    unsigned vA[2][2], vAn[2][2];
    const size_t kstep = (size_t)(BK * 2);
    const size_t hstep = (size_t)HALF * K * (FP8 ? 1 : 2);
    const size_t tstep = 2 * hstep;
    const unsigned ldsw = (unsigned)wid * 1024u;
    const int aoff = lds_byte(wr * 64 + fr, fq * 8), boff = lds_byte(wc * 32 + fr, fq * 8);
#define PG8_SA(b, h) (((b) * 2 + (h)) * HTB)
#define PG8_SB(b, h) ((4 + (b) * 2 + (h)) * HTB)
#define PG8_STAGE(bufoff, gbase, voff) do { _Pragma("unroll") for (int _i = 0; _i < 2; ++_i) \
        __builtin_amdgcn_global_load_lds((const unsigned*)((const char*)(gbase) + (voff)[_i]), (PG8_LAS unsigned*)(lds + (bufoff) + ldsw + _i * 8192), 16, 0, 0); } while (0)
#define PG8_GVOFF(u, dst) do { if constexpr (Sched::GATHER) { _Pragma("unroll") for (int _h = 0; _h < 2; ++_h) _Pragma("unroll") for (int _i = 0; _i < 2; ++_i) dst[_h][_i] = S.a_rowoff(u, _h * HALF + RA[_i]) + CA[_i]; } } while (0)
#define PG8_STAGE_A(bufoff, gbase, h, nx) do { if constexpr (Sched::GATHER) { unsigned _v[2]; _Pragma("unroll") for (int _i = 0; _i < 2; ++_i) _v[_i] = (nx) ? vAn[h][_i] : vA[h][_i]; PG8_STAGE(bufoff, gbase, _v); } \
        else { PG8_STAGE(bufoff, (gbase) + (h) * hstep, voffA); } } while (0)
#define PG8_LDA(dst, b, h) do { _Pragma("unroll") for (int m = 0; m < 4; ++m) _Pragma("unroll") for (int k = 0; k < 2; ++k) dst[m][k] = *(const PG8_LAS bf16x8*)(lds + PG8_SA(b, h) + aoff + m * 2048 + k * 1024); } while (0)
#define PG8_LDB(dst, b, h) do { _Pragma("unroll") for (int n = 0; n < 2; ++n) _Pragma("unroll") for (int k = 0; k < 2; ++k) dst[n][k] = *(const PG8_LAS bf16x8*)(lds + PG8_SB(b, h) + boff + n * 2048 + k * 1024); } while (0)
#define PG8_MMA(ai, bj, At, Bt) do { __builtin_amdgcn_s_setprio(1); \
        if constexpr (FP8) { typedef int i32x8_ __attribute__((ext_vector_type(8))); typedef int i32x4_ __attribute__((ext_vector_type(4))); \
            _Pragma("unroll") for (int m = 0; m < 4; ++m) _Pragma("unroll") for (int n = 0; n < 2; ++n) { \
                const i32x8_ _av = __builtin_shufflevector(__builtin_bit_cast(i32x4_, At[m][0]), __builtin_bit_cast(i32x4_, At[m][1]), 0, 1, 2, 3, 4, 5, 6, 7); \
                const i32x8_ _bv = __builtin_shufflevector(__builtin_bit_cast(i32x4_, Bt[n][0]), __builtin_bit_cast(i32x4_, Bt[n][1]), 0, 1, 2, 3, 4, 5, 6, 7); \
                asm volatile("v_mfma_scale_f32_16x16x128_f8f6f4 %0, %1, %2, %0, %3, %3 op_sel_hi:[0,0,0]" : "+v"(acc[ai][bj][m][n]) : "v"(_bv), "v"(_av), "v"(mx_one)); } } \
        else { _Pragma("unroll") for (int m = 0; m < 4; ++m) _Pragma("unroll") for (int n = 0; n < 2; ++n) _Pragma("unroll") for (int k = 0; k < 2; ++k) \
            acc[ai][bj][m][n] = __builtin_amdgcn_mfma_f32_16x16x32_bf16(Bt[n][k], At[m][k], acc[ai][bj][m][n], 0, 0, 0); } \
        __builtin_amdgcn_s_setprio(0); } while (0)
#define PG8_WAIT_V(n) asm volatile("s_waitcnt vmcnt(" #n ")" ::: "memory")
#define PG8_WAIT_L(n) asm volatile("s_waitcnt lgkmcnt(" #n ")" ::: "memory")
#define PG8_BAR __builtin_amdgcn_s_barrier()
#define PG8_SCHED __builtin_amdgcn_sched_barrier(0)
    Unit cur, nxt; int ui = 0;
    if (!S.next(0, cur)) return;
    f32x4 acc[2][2][4][2];
#pragma unroll
    for (int a = 0; a < 2; ++a)
#pragma unroll
        for (int b = 0; b < 2; ++b)
#pragma unroll
            for (int m = 0; m < 4; ++m)
#pragma unroll
                for (int n = 0; n < 2; ++n) acc[a][b][m][n] = (f32x4){0.f, 0.f, 0.f, 0.f};
    bf16x8 At[4][2], B0[2][2], B1[2][2];
    const char* cA = (const char*)g.A + (Sched::GATHER ? (size_t)0 : (size_t)cur.pm * tstep); const char* cB = (const char*)g.Bt + (size_t)cur.pn * tstep;
    S.a_ready(cur);
    PG8_GVOFF(cur, vA);
    if constexpr (SP2) {
        PG8_STAGE(PG8_SB(0, 0), cB, voffB); PG8_STAGE(PG8_SB(0, 1), cB + hstep, voffB); PG8_STAGE_A(PG8_SA(0, 0), cA, 0, false); PG8_STAGE_A(PG8_SA(0, 1), cA, 1, false);
        if (wr == 1) PG8_BAR;
        PG8_WAIT_V(2); PG8_BAR;
        PG8_STAGE(PG8_SB(1, 0), cB + kstep, voffB); PG8_STAGE_A(PG8_SA(1, 0), cA + kstep, 0, false); PG8_STAGE(PG8_SB(1, 1), cB + hstep + kstep, voffB);
        PG8_WAIT_V(6); PG8_BAR;
    } else {
        PG8_STAGE(PG8_SB(0, 0), cB, voffB); PG8_STAGE_A(PG8_SA(0, 0), cA, 0, false); PG8_STAGE(PG8_SB(0, 1), cB + hstep, voffB); PG8_STAGE_A(PG8_SA(0, 1), cA, 1, false);
        if (wr == 1) PG8_BAR;
        PG8_WAIT_V(4); PG8_BAR;
        PG8_STAGE(PG8_SB(1, 0), cB + kstep, voffB); PG8_STAGE_A(PG8_SA(1, 0), cA + kstep, 0, false); PG8_STAGE(PG8_SB(1, 1), cB + hstep + kstep, voffB);
        PG8_WAIT_V(6); PG8_BAR;
    }
    for (;;) {
        const bool has_next = S.next(ui + 1, nxt);
        const char* nA = (has_next && !Sched::GATHER) ? (const char*)g.A + (size_t)nxt.pm * tstep : cA; const char* nB = has_next ? (const char*)g.Bt + (size_t)nxt.pn * tstep : cB;
        if constexpr (Sched::GATHER) { if (has_next) { PG8_GVOFF(nxt, vAn); } else { _Pragma("unroll") for (int _h = 0; _h < 2; ++_h) _Pragma("unroll") for (int _i = 0; _i < 2; ++_i) vAn[_h][_i] = vA[_h][_i]; } }
#pragma unroll 1
        for (int t = 0; t < nt; t += 2) {
            const bool last = (t == nt - 2);
            const char* a1 = cA + (size_t)(t + 1) * kstep;
            const char* a2 = last ? nA : cA + (size_t)(t + 2) * kstep; const char* b2 = last ? nB : cB + (size_t)(t + 2) * kstep;
            const char* a3 = a2 + kstep; const char* b3 = b2 + kstep;
            if (last && has_next) S.a_ready(nxt);
            if constexpr (SP2) {
            PG8_LDB(B0, 0, 0); PG8_LDB(B1, 0, 1); PG8_SCHED; PG8_LDA(At, 0, 0); PG8_STAGE_A(PG8_SA(1, 1), a1, 1, false);
            PG8_WAIT_V(8); PG8_WAIT_L(0); PG8_BAR; PG8_MMA(0, 0, At, B0); PG8_MMA(0, 1, At, B1); PG8_BAR; PG8_SCHED;
            PG8_LDA(At, 0, 1); PG8_STAGE(PG8_SB(0, 0), b2, voffB); PG8_STAGE(PG8_SB(0, 1), b2 + hstep, voffB); PG8_STAGE_A(PG8_SA(0, 0), a2, 0, last);
            PG8_WAIT_V(8); PG8_WAIT_L(0); PG8_BAR; PG8_MMA(1, 0, At, B0); PG8_MMA(1, 1, At, B1); PG8_BAR; PG8_SCHED;
            PG8_LDB(B0, 1, 0); PG8_LDB(B1, 1, 1); PG8_SCHED; PG8_LDA(At, 1, 0); PG8_STAGE_A(PG8_SA(0, 1), a2, 1, last);
            PG8_WAIT_V(8); PG8_WAIT_L(0); PG8_BAR; PG8_MMA(0, 0, At, B0); PG8_MMA(0, 1, At, B1); PG8_BAR; PG8_SCHED;
            PG8_LDA(At, 1, 1); PG8_STAGE(PG8_SB(1, 0), b3, voffB); PG8_STAGE(PG8_SB(1, 1), b3 + hstep, voffB); PG8_STAGE_A(PG8_SA(1, 0), a3, 0, last);
            PG8_WAIT_V(8); PG8_WAIT_L(0); PG8_BAR; PG8_MMA(1, 0, At, B0); PG8_MMA(1, 1, At, B1); PG8_BAR; PG8_SCHED;
            } else {
            PG8_LDB(B0, 0, 0); PG8_SCHED; PG8_LDA(At, 0, 0); PG8_STAGE_A(PG8_SA(1, 1), a1, 1, false);
            PG8_WAIT_L(8); PG8_BAR; PG8_WAIT_L(0); PG8_MMA(0, 0, At, B0); PG8_BAR; PG8_SCHED;
            PG8_LDB(B1, 0, 1); PG8_STAGE(PG8_SB(0, 0), b2, voffB);
            PG8_BAR; PG8_WAIT_L(0); PG8_MMA(0, 1, At, B1); PG8_BAR;
            PG8_LDA(At, 0, 1); PG8_STAGE_A(PG8_SA(0, 0), a2, 0, last);
            PG8_BAR; PG8_WAIT_L(0); PG8_MMA(1, 0, At, B0); PG8_BAR; PG8_SCHED;
            PG8_STAGE(PG8_SB(0, 1), b2 + hstep, voffB);
            PG8_WAIT_V(6); PG8_BAR; PG8_MMA(1, 1, At, B1); PG8_BAR;
            PG8_LDB(B0, 1, 0); PG8_SCHED; PG8_LDA(At, 1, 0); PG8_STAGE_A(PG8_SA(0, 1), a2, 1, last);
            PG8_WAIT_L(8); PG8_BAR; PG8_WAIT_L(0); PG8_MMA(0, 0, At, B0); PG8_BAR; PG8_SCHED;
            PG8_LDB(B1, 1, 1); PG8_STAGE(PG8_SB(1, 0), b3, voffB);
            PG8_BAR; PG8_WAIT_L(0); PG8_MMA(0, 1, At, B1); PG8_BAR;
            PG8_LDA(At, 1, 1); PG8_STAGE_A(PG8_SA(1, 0), a3, 0, last);
            PG8_BAR; PG8_WAIT_L(0); PG8_MMA(1, 0, At, B0); PG8_BAR; PG8_SCHED;
            PG8_STAGE(PG8_SB(1, 1), b3 + hstep, voffB);
            PG8_WAIT_V(6); PG8_BAR; PG8_MMA(1, 1, At, B1); PG8_BAR;
            }
        }
        if constexpr (ALIGN_EPI) { if (wr == 0) PG8_BAR; }
        if constexpr (!Epi::AFTER_DRAIN) { E(acc, cur, wr, wc, fr, fq); S.done(cur); }
        if (!has_next) break;
#pragma unroll
        for (int a = 0; a < 2; ++a)
#pragma unroll
            for (int b = 0; b < 2; ++b)
#pragma unroll
                for (int m = 0; m < 4; ++m)
#pragma unroll
                    for (int n = 0; n < 2; ++n) acc[a][b][m][n] = (f32x4){0.f, 0.f, 0.f, 0.f};
        cur = nxt; cA = nA; cB = nB; ++ui;
        if constexpr (Sched::GATHER) { _Pragma("unroll") for (int _h = 0; _h < 2; ++_h) _Pragma("unroll") for (int _i = 0; _i < 2; ++_i) vA[_h][_i] = vAn[_h][_i]; }
        if constexpr (ALIGN_EPI) { if (wr == 1) PG8_BAR; }
    }
    PG8_WAIT_V(0);
    if constexpr (!ALIGN_EPI) { if (wr == 0) PG8_BAR; }
    PG8_BAR;
    if constexpr (Epi::AFTER_DRAIN) { E.fused(acc, cur, wr, wc, fr, fq, lds, wid, lane); S.done(cur); }
#undef PG8_SA
#undef PG8_SB
#undef PG8_STAGE
#undef PG8_GVOFF
#undef PG8_STAGE_A
#undef PG8_LDA
#undef PG8_LDB
#undef PG8_MMA
#undef PG8_WAIT_V
#undef PG8_WAIT_L
#undef PG8_BAR
#undef PG8_SCHED
}
}

#define XB_TMO      128
#define XB_XCNT(j)  (256  + 64 * (j))
#define XB_XSUB(j)  (1280 + 64 * (j))
#define XB_XGEN(j)  (2304 + 64 * (j))
#define XB_TOP      3328
#define XB_TOPGEN   3392
#define XCD_BAR_WORDS 3456
#define XB_SPIN_CAP (1u << 18)
#define LAS __attribute__((address_space(3)))

__device__ __forceinline__ unsigned xb_ld(unsigned* p)              { return __hip_atomic_load(p, __ATOMIC_RELAXED, __HIP_MEMORY_SCOPE_AGENT); }
__device__ __forceinline__ unsigned xb_add(unsigned* p, unsigned v) { return __hip_atomic_fetch_add(p, v, __ATOMIC_RELAXED, __HIP_MEMORY_SCOPE_AGENT); }
__device__ __forceinline__ unsigned xb_xcc_id() { return (unsigned)__builtin_amdgcn_s_getreg((3 << 11) | 20) & 0xFu; }
#define XB_SPIN(cond, bar) do { unsigned _sp = 0; while (cond) { __builtin_amdgcn_s_sleep(1); \
    if ((++_sp & 255u) == 0u) { if (xb_ld(&(bar)[XB_TMO])) break; if (_sp > XB_SPIN_CAP) { atomicAdd(&(bar)[XB_TMO], 1u); break; } } } } while (0)

struct XcdBarrier {
    unsigned* bar; unsigned x;
    volatile LAS unsigned* st;
};

__device__ __forceinline__ XcdBarrier xcd_barrier_post(unsigned* bar, volatile LAS unsigned* st) {
    XcdBarrier b; b.bar = bar; b.x = xb_xcc_id(); b.st = st;
    if (threadIdx.x == 0) (void)xb_add(&bar[XB_XCNT(b.x)], 1u);
    return b;
}
__device__ __forceinline__ void xcd_barrier_complete(unsigned* bar, unsigned x, unsigned& nloc, unsigned& nx) {
    const unsigned G = gridDim.x * gridDim.y * gridDim.z;
    unsigned sum, cnt, mine, sp = 0u;
    for (;;) {
        sum = 0u; cnt = 0u; mine = 0u;
#pragma unroll
        for (unsigned j = 0; j < 16; ++j) { const unsigned c = xb_ld(&bar[XB_XCNT(j)]); sum += c; cnt += (c > 0u) ? 1u : 0u; mine = (j == x) ? c : mine; }
        if (sum == G) break;
        __builtin_amdgcn_s_sleep(1);
        if ((++sp & 255u) == 0u) { if (xb_ld(&bar[XB_TMO])) break; if (sp > XB_SPIN_CAP) { atomicAdd(&bar[XB_TMO], 1u); break; } }
    }
    nloc = mine > 0u ? mine : 1u; nx = cnt > 0u ? cnt : 1u;
}

__device__ __forceinline__ void xcd_barrier(const XcdBarrier& b) {
    asm volatile("s_waitcnt vmcnt(0)" ::: "memory");
    __syncthreads();
    if (threadIdx.x == 0) {
        unsigned* bar = b.bar;
        __builtin_amdgcn_s_waitcnt(0);
        unsigned nloc = b.st[0], nx = b.st[1];
        if (nloc == 0u) { xcd_barrier_complete(bar, b.x, nloc, nx); b.st[0] = nloc; b.st[1] = nx; }
        const unsigned old = xb_add(&bar[XB_XSUB(b.x)], 1u);
        const unsigned gen = old / nloc;
        if (old + 1u == (gen + 1u) * nloc) {
            __builtin_amdgcn_fence(__ATOMIC_RELEASE, "agent");
            asm volatile("s_waitcnt vmcnt(0)" ::: "memory");
            const unsigned og = xb_add(&bar[XB_TOP], 1u);
            const unsigned tg = og / nx;
            if (og + 1u == (tg + 1u) * nx) xb_add(&bar[XB_TOPGEN], 1u);
            else XB_SPIN(xb_ld(&bar[XB_TOPGEN]) == tg, bar);
            __builtin_amdgcn_fence(__ATOMIC_ACQUIRE, "agent");
            xb_add(&bar[XB_XGEN(b.x)], 1u);
            asm volatile("s_waitcnt vmcnt(0)" ::: "memory");
        } else {
            XB_SPIN(xb_ld(&bar[XB_XGEN(b.x)]) == gen, bar);
            __builtin_amdgcn_fence(__ATOMIC_ACQUIRE, "agent");
            asm volatile("s_waitcnt vmcnt(0)" ::: "memory");
        }
    }
    __syncthreads();
}


#ifndef PHMASK
#define PHMASK 0x1ffff
#endif
#define EN(j) (((PHMASK) >> (j)) & 1)
#ifndef GEMM_ALIGN
#define GEMM_ALIGN true
#endif
#ifndef GEMM_SP2
#define GEMM_SP2 true
#endif
#ifndef STORE_T
#define STORE_T 1
#endif
#ifndef STAG_D
#define STAG_D 0
#endif
#ifndef STAG_GU
#define STAG_GU 0
#endif
#ifndef MALL_WARM
#define MALL_WARM 1
#endif
#ifndef L3MASK
#define L3MASK 7
#endif
#ifndef MK_SPLIT
#define MK_SPLIT 0
#endif

#define GAS __attribute__((address_space(1)))
typedef unsigned short bf16;
typedef unsigned v4u __attribute__((ext_vector_type(4)));
typedef unsigned v2u __attribute__((ext_vector_type(2)));
typedef float f32x4 __attribute__((ext_vector_type(4)));
typedef short bf16x8 __attribute__((ext_vector_type(8)));
using pg8::Unit;

constexpr int T = 16384, D = 1024, SEQ = 2048, NL = 4, DIN = 2320, NE = 128;
constexpr float EPS = 1e-6f;
constexpr int NWAVES = 8, NTHR = 512;
constexpr size_t MiB = 1u << 20;
constexpr size_t WS_CTL = 0, CTL_BYTES = 1 * MiB;
constexpr size_t WS_WIN = 1 * MiB, WS_WPQ = 17 * MiB, WS_WOUT = 21 * MiB, WS_RS = 29 * MiB, WS_PLEIN = 35 * MiB, WS_PLEG = 37 * MiB, WS_GWS = 45 * MiB, WS_CSW = 46 * MiB, WS_DFT = 47 * MiB;
constexpr size_t RS_L = 768 * 1024 * 2;
constexpr size_t WS_WGU = 64 * MiB, WGU_L = 128 * MiB;
constexpr size_t WS_WD = 576 * MiB, WD_L = 129 * 1024 * 256 * 2;
constexpr size_t WS_H = 838 * MiB, WS_XM = 902 * MiB, WS_Y = 934 * MiB, WS_HB = 1222 * MiB, WS_Z = 1254 * MiB, WS_GATES = 1318 * MiB, WS_PQT = 1319 * MiB, WS_MIX = 1335 * MiB;
constexpr size_t WS_CLOC = 1367 * MiB, WS_CPREV = 1399 * MiB, WS_SMALL = 1415 * MiB, WS_LOGIT = 1416 * MiB, WS_TOPK = 1424 * MiB, WS_ACT = 1426 * MiB, WS_E = 1498 * MiB, WS_GE = 1626 * MiB, WS_PB = 1658 * MiB, WS_LIST = 1690 * MiB;
constexpr size_t WS_XM8 = 1698 * MiB;
constexpr size_t WS_END = 1714 * MiB;
constexpr size_t WS_FLAGS = 63 * MiB, FLAGS_BYTES = 1 * MiB;
constexpr int NGU = 128;
constexpr float SX8 = 8.f, SW8 = 64.f, SA8 = 8.f;
constexpr size_t ACT8_OFF = 8 * MiB, WD8_OFF = 1 * MiB;
constexpr size_t WS_PQF = WS_DFT + 8 * MiB;
constexpr int LCAP = 16384;
constexpr int CW_BAR = 4096;
constexpr int CW_CNT = 240000;
static_assert((CW_CNT + 4 * 256) * 4 <= (int)CTL_BYTES && CW_BAR + 64 * XCD_BAR_WORDS <= CW_CNT, "ctl map");
constexpr int LDS_RING = 131072, LDS_TBL = LDS_RING, LDS_MISC = LDS_RING + 2048, LDS_DESC = LDS_RING + 1104, LDS_ROWTAB = LDS_RING + 4096, LDS_BYTES = 155648;

__device__ __forceinline__ unsigned f2bf(float f) { unsigned u = __float_as_uint(f); return (u + 0x7fffu + ((u >> 16) & 1u)) >> 16; }
__device__ __forceinline__ unsigned pk2(float lo, float hi) { unsigned r; asm("v_cvt_pk_bf16_f32 %0, %1, %2" : "=v"(r) : "v"(lo), "v"(hi)); return r; }
__device__ __forceinline__ float bf2f(unsigned b) { return __uint_as_float(b << 16); }
__device__ __forceinline__ float bflo(unsigned w) { return __uint_as_float(w << 16); }
__device__ __forceinline__ float bfhi(unsigned w) { return __uint_as_float(w & 0xffff0000u); }
__device__ __forceinline__ float sigmoidf_(float x) { return __builtin_amdgcn_rcpf(1.f + __expf(-x)); }
__device__ __forceinline__ float siluf_(float x) { return x * __builtin_amdgcn_rcpf(1.f + __expf(-x)); }
__device__ __forceinline__ float geluf_(float x) { const float t = 1.5957691216f * (x + 0.044715f * x * x * x); return x * __builtin_amdgcn_rcpf(1.f + __expf(-t)); }
__device__ __forceinline__ float logsigf_(float x) { return fminf(x, 0.f) - __logf(1.f + __expf(-fabsf(x))); }
__device__ __forceinline__ float wave_sum(float v) {
#pragma unroll
    for (int o = 1; o < 64; o <<= 1) v += __shfl_xor(v, o);
    return v;
}
__device__ __forceinline__ int otid() { int t = threadIdx.x; asm volatile("" : "+v"(t)); return t; }
#define LDS_FENCE() asm volatile("s_waitcnt lgkmcnt(0)" ::: "memory")
#define MFMA16(a, b, c) __builtin_amdgcn_mfma_f32_16x16x32_bf16((a), (b), (c), 0, 0, 0)


__device__ __forceinline__ v4u lane_xpose(v4u w, int lane) {
    const int src = (((lane & 3) << 4) | (lane >> 2)) << 2; v4u o;
    o.x = (unsigned)__builtin_amdgcn_ds_bpermute(src, (int)w.x); o.y = (unsigned)__builtin_amdgcn_ds_bpermute(src, (int)w.y);
    o.z = (unsigned)__builtin_amdgcn_ds_bpermute(src, (int)w.z); o.w = (unsigned)__builtin_amdgcn_ds_bpermute(src, (int)w.w); return o;
}


__device__ __forceinline__ void stagger(int q, unsigned ticks) {
    if (ticks == 0u || q == 0) return;
    const unsigned long long t0 = __builtin_amdgcn_s_memrealtime(); const unsigned long long d = (unsigned long long)q * ticks;
    while (__builtin_amdgcn_s_memrealtime() - t0 < d) __builtin_amdgcn_s_sleep(8);
}

struct RangeOrder {
    static constexpr bool GATHER = false;
    int start, count, nN;
    __device__ __forceinline__ bool next(int i, Unit& u) const { if (i >= count) return false; const int j = start + i; u.pm = j / nN; u.pn = j % nN; return true; }
    __device__ __forceinline__ void a_ready(const Unit&) const {}
    __device__ __forceinline__ void done(const Unit&) const {}
};
struct StackOrder {
    static constexpr bool GATHER = false;
    int nl, nM, nN, G, c;
    __device__ __forceinline__ bool next(int i, Unit& u) const { const int L = i * G + c; if (L >= nl * nM * nN) return false; const int l = L / (nM * nN), r = L % (nM * nN); u.pm = l * nM + r / nN; u.pn = l * nN + r % nN; return true; }
    __device__ __forceinline__ void a_ready(const Unit&) const {}
    __device__ __forceinline__ void done(const Unit&) const {}
};
template <int MODE> struct MoeOrder {
    static constexpr bool GATHER = true;
    const LAS int* desc; const LAS int* rowtab; int nunits, shift; unsigned rowbytes; unsigned* flags;
    __device__ __forceinline__ bool next(int i, Unit& u) const {
        if (i >= nunits) return false;
        u.pn = __builtin_amdgcn_readfirstlane(desc[3 * i]); u.aux0 = i * 256; u.aux1 = __builtin_amdgcn_readfirstlane(desc[3 * i + 1]); u.pm = __builtin_amdgcn_readfirstlane(desc[3 * i + 2]); return true; }
    __device__ __forceinline__ unsigned a_rowoff(const Unit& u, int r) const { return (unsigned)(rowtab[u.aux0 + r] >> shift) * rowbytes; }
    __device__ __forceinline__ void a_ready(const Unit& u) const {
        if (MODE == 2) {
            if (threadIdx.x < 64) {
                const unsigned long long t0 = __builtin_amdgcn_s_memrealtime();
                while ((unsigned)__builtin_amdgcn_readfirstlane(__hip_atomic_load(flags + 64 * u.pm, __ATOMIC_RELAXED, __HIP_MEMORY_SCOPE_AGENT)) < 16u) {
                    if (__builtin_amdgcn_s_memrealtime() - t0 > 2000000ull) break;
                    __builtin_amdgcn_s_sleep(2); }
                __builtin_amdgcn_fence(__ATOMIC_ACQUIRE, "agent");
                asm volatile("s_waitcnt vmcnt(0)" ::: "memory");
            }
            asm volatile("" ::: "memory"); __builtin_amdgcn_s_barrier(); asm volatile("" ::: "memory");
        }
    }
    __device__ __forceinline__ void done(const Unit& u) const {
        if (MODE == 1) {
            asm volatile("s_waitcnt vmcnt(0)" ::: "memory");
            if ((threadIdx.x & 63) == 0) __hip_atomic_fetch_add(flags + 64 * u.pm, 1u, __ATOMIC_RELAXED, __HIP_MEMORY_SCOPE_AGENT);
        }
    }
};
struct EpiStoreBf16 {
    static constexpr bool PERM = true, AFTER_DRAIN = false;
    bf16* O; int ldc; int cmask;
    __device__ __forceinline__ void operator()(const f32x4 (&acc)[2][2][4][2], const Unit& u, int wr, int wc, int fr, int fq) const {
        const int lane = fq * 16 + fr, frs = STORE_T ? (lane >> 2) : fr, fqs = STORE_T ? (lane & 3) : fq;
        const int row0 = u.pm * 256 + wr * 64 + frs, col0 = (u.pn & cmask) * 256 + wc * 32 + 8 * fqs;
#pragma unroll
        for (int ai = 0; ai < 2; ++ai)
#pragma unroll
            for (int m = 0; m < 4; ++m) { bf16* rowp = O + (size_t)(row0 + ai * 128 + m * 16) * ldc + col0;
#pragma unroll
                for (int bj = 0; bj < 2; ++bj) { const f32x4 v0 = acc[ai][bj][m][0], v1 = acc[ai][bj][m][1];
                    v4u w; w.x = pk2(v0[0], v0[1]); w.y = pk2(v0[2], v0[3]); w.z = pk2(v1[0], v1[1]); w.w = pk2(v1[2], v1[3]);
                    if (STORE_T) w = lane_xpose(w, lane);
                    *(v4u*)(rowp + bj * 128) = w; } }
    }
};
struct EpiPQ {
    static constexpr bool PERM = true, AFTER_DRAIN = false;
    bf16* O;
    __device__ __forceinline__ void operator()(const f32x4 (&acc)[2][2][4][2], const Unit& u, int wr, int wc, int fr, int fq) const {
        const int row0 = u.pm * 256 + wr * 64 + fr, t0 = u.pn * 256 + wc * 32 + 8 * fq;
#pragma unroll
        for (int ai = 0; ai < 2; ++ai)
#pragma unroll
            for (int m = 0; m < 4; ++m) { const int c = row0 + ai * 128 + m * 16;
#pragma unroll
                for (int bj = 0; bj < 2; ++bj) { const int t = t0 + bj * 128, b = t >> 11, s = t & 2047;
                    const f32x4 v0 = acc[ai][bj][m][0], v1 = acc[ai][bj][m][1];
                    v4u w; w.x = pk2(v0[0], v0[1]); w.y = pk2(v0[2], v0[3]); w.z = pk2(v1[0], v1[1]); w.w = pk2(v1[2], v1[3]);
                    *(v4u*)(O + ((size_t)(b * 256 + (c & 255)) * 4096 + (c >> 8) * 2048 + s)) = w; } }
    }
};
struct EpiFourier {
    static constexpr bool PERM = true, AFTER_DRAIN = false;
    bf16* O;
    __device__ __forceinline__ void operator()(const f32x4 (&acc)[2][2][4][2], const Unit& u, int wr, int wc, int fr, int fq) const {
        const int row0 = u.pm * 256 + wr * 64 + fr, c0 = wc * 32 + 8 * fq, b = u.pn;
#pragma unroll
        for (int ai = 0; ai < 2; ++ai)
#pragma unroll
            for (int m = 0; m < 4; ++m) { bf16* rowp = O + (size_t)(b * 2048 + row0 + ai * 128 + m * 16) * 1024 + c0;
#pragma unroll
                for (int bj = 0; bj < 2; ++bj) { const f32x4 v0 = acc[ai][bj][m][0], v1 = acc[ai][bj][m][1];
                    v4u w; w.x = pk2(v0[0], v0[1]); w.y = pk2(v0[2], v0[3]); w.z = pk2(v1[0], v1[1]); w.w = pk2(v1[2], v1[3]);
                    *(v4u*)(rowp + bj * 128) = w; } }
    }
};
struct EpiResid {
    static constexpr bool PERM = false, AFTER_DRAIN = false;
    float* H;
    __device__ __forceinline__ void operator()(const f32x4 (&acc)[2][2][4][2], const Unit& u, int wr, int wc, int fr, int fq) const {
        const int row0 = u.pm * 256 + wr * 64 + fr, col0 = u.pn * 256 + wc * 32 + 4 * fq;
#pragma unroll
        for (int ai = 0; ai < 2; ++ai)
#pragma unroll
            for (int m = 0; m < 4; ++m) { float* rowp = H + (size_t)(row0 + ai * 128 + m * 16) * D + col0;
#pragma unroll
                for (int bj = 0; bj < 2; ++bj)
#pragma unroll
                    for (int n = 0; n < 2; ++n) { f32x4* p = (f32x4*)(rowp + bj * 128 + n * 16); *p = *p + acc[ai][bj][m][n]; } }
    }
};
struct EpiRouterShared {
    static constexpr bool PERM = true, AFTER_DRAIN = false;
    float* Lg; bf16* Act;
    __device__ __forceinline__ void operator()(const f32x4 (&acc)[2][2][4][2], const Unit& u, int wr, int wc, int fr, int fq) const {
        const int row0 = u.pm * 256 + wr * 64 + fr;
        if (u.pn == 0) {
#pragma unroll
            for (int ai = 0; ai < 2; ++ai)
#pragma unroll
                for (int m = 0; m < 4; ++m) { float* rowp = Lg + (size_t)(row0 + ai * 128 + m * 16) * 128 + wc * 32 + 8 * fq;
                    *(f32x4*)rowp = acc[ai][0][m][0]; *(f32x4*)(rowp + 4) = acc[ai][0][m][1]; }
        } else {
            const int col0 = (u.pn - 1) * 128 + wc * 32 + 8 * fq;
#pragma unroll
            for (int ai = 0; ai < 2; ++ai)
#pragma unroll
                for (int m = 0; m < 4; ++m) { float o[8];
#pragma unroll
                    for (int n = 0; n < 2; ++n)
#pragma unroll
                        for (int i = 0; i < 4; ++i) o[n * 4 + i] = siluf_(acc[ai][0][m][n][i]) * acc[ai][1][m][n][i];
                    v4u w; w.x = pk2(o[0], o[1]); w.y = pk2(o[2], o[3]); w.z = pk2(o[4], o[5]); w.w = pk2(o[6], o[7]);
                    *(v4u*)(Act + (size_t)(row0 + ai * 128 + m * 16) * 256 + col0) = w; }
        }
    }
};
struct EpiSwigluScatter {
    static constexpr bool PERM = true, AFTER_DRAIN = false;
    unsigned char* Act; const LAS int* list; float sc;
    __device__ __forceinline__ void operator()(const f32x4 (&acc)[2][2][4][2], const Unit& u, int wr, int wc, int fr, int fq) const {
        const int r0 = wr * 64 + fr, col0 = (u.pn & 1) * 128 + wc * 32 + 8 * fq;
#pragma unroll
        for (int ai = 0; ai < 2; ++ai)
#pragma unroll
            for (int m = 0; m < 4; ++m) { const int r = r0 + ai * 128 + m * 16;
                if (r < u.aux1) { const int pid = list[u.aux0 + r]; float o[8];
#pragma unroll
                    for (int n = 0; n < 2; ++n)
#pragma unroll
                        for (int i = 0; i < 4; ++i) o[n * 4 + i] = siluf_(acc[ai][0][m][n][i] * sc) * (acc[ai][1][m][n][i] * sc);
                    v2u w; w.x = (unsigned)__builtin_amdgcn_cvt_pk_fp8_f32(o[2] * SA8, o[3] * SA8, __builtin_amdgcn_cvt_pk_fp8_f32(o[0] * SA8, o[1] * SA8, 0, false), true);
                    w.y = (unsigned)__builtin_amdgcn_cvt_pk_fp8_f32(o[6] * SA8, o[7] * SA8, __builtin_amdgcn_cvt_pk_fp8_f32(o[4] * SA8, o[5] * SA8, 0, false), true);
                    *(v2u*)(Act + (size_t)pid * 256 + col0) = w; } }
    }
};
struct EpiYScatter {
    static constexpr bool PERM = true, AFTER_DRAIN = false;
    unsigned char* Y; const LAS int* list; float sc;
    __device__ __forceinline__ void operator()(const f32x4 (&acc)[2][2][4][2], const Unit& u, int wr, int wc, int fr, int fq) const {
        const int lane = fq * 16 + fr, frs = lane >> 2, fqs = lane & 3;
        const int r0 = wr * 64 + frs, col0 = (u.pn & 3) * 256 + wc * 64 + 16 * fqs;
#pragma unroll
        for (int ai = 0; ai < 2; ++ai)
#pragma unroll
            for (int m = 0; m < 4; ++m) { const int r = r0 + ai * 128 + m * 16; const bool ok = r < u.aux1; const int pid = ok ? list[u.aux0 + r] : 0;
                v4u w;
                { const f32x4 a0 = acc[ai][0][m][0] * sc, a1 = acc[ai][0][m][1] * sc, a2 = acc[ai][1][m][0] * sc, a3 = acc[ai][1][m][1] * sc;
                  w.x = (unsigned)__builtin_amdgcn_cvt_pk_fp8_f32(a0[2], a0[3], __builtin_amdgcn_cvt_pk_fp8_f32(a0[0], a0[1], 0, false), true);
                  w.y = (unsigned)__builtin_amdgcn_cvt_pk_fp8_f32(a1[2], a1[3], __builtin_amdgcn_cvt_pk_fp8_f32(a1[0], a1[1], 0, false), true);
                  w.z = (unsigned)__builtin_amdgcn_cvt_pk_fp8_f32(a2[2], a2[3], __builtin_amdgcn_cvt_pk_fp8_f32(a2[0], a2[1], 0, false), true);
                  w.w = (unsigned)__builtin_amdgcn_cvt_pk_fp8_f32(a3[2], a3[3], __builtin_amdgcn_cvt_pk_fp8_f32(a3[0], a3[1], 0, false), true); }
                w = lane_xpose(w, lane);
                if (ok) *(v4u*)(Y + (size_t)pid * 1024 + col0) = w; }
    }
};
struct EpiPleGate {
    static constexpr bool PERM = true, AFTER_DRAIN = false;
    bf16* GE; const bf16* E;
    __device__ __forceinline__ void operator()(const f32x4 (&acc)[2][2][4][2], const Unit& u, int wr, int wc, int fr, int fq) const {
        const int row0 = u.pm * 256 + wr * 64 + fr, col0 = u.pn * 256 + wc * 32 + 8 * fq;
#pragma unroll
        for (int ai = 0; ai < 2; ++ai)
#pragma unroll
            for (int m = 0; m < 4; ++m) { const size_t off = (size_t)(row0 + ai * 128 + m * 16) * D + col0;
#pragma unroll
                for (int bj = 0; bj < 2; ++bj) { const v4u e = __builtin_nontemporal_load((const v4u*)(E + off + bj * 128)); const f32x4 v0 = acc[ai][bj][m][0], v1 = acc[ai][bj][m][1];
                    v4u w; w.x = pk2(sigmoidf_(v0[0]) * bflo(e.x), sigmoidf_(v0[1]) * bfhi(e.x)); w.y = pk2(sigmoidf_(v0[2]) * bflo(e.y), sigmoidf_(v0[3]) * bfhi(e.y));
                    w.z = pk2(sigmoidf_(v1[0]) * bflo(e.z), sigmoidf_(v1[1]) * bfhi(e.z)); w.w = pk2(sigmoidf_(v1[2]) * bflo(e.w), sigmoidf_(v1[3]) * bfhi(e.w));
                    *(v4u*)(GE + off + bj * 128) = w; } }
    }
};

__device__ __forceinline__ void transpose_item(const float* W, int ldw, int k0, int n0, bf16* dst, int Kd, LAS float* scr, int lane, int perm16 = 0, int fp8 = 0) {
#pragma unroll 8
    for (int i = 0; i < 32; ++i) { const int kk = 2 * i + (lane >> 5); scr[kk * 33 + (lane & 31)] = __builtin_nontemporal_load(W + (size_t)(k0 + kk) * ldw + n0 + (lane & 31)); }
    LDS_FENCE();
    const int c = lane & 7;
#pragma unroll
    for (int j = 0; j < 4; ++j) { const int n = (lane >> 3) + 8 * j; const LAS float* s = scr + (8 * c) * 33 + n;
        v4u o; o.x = pk2(s[0 * 33], s[1 * 33]); o.y = pk2(s[2 * 33], s[3 * 33]); o.z = pk2(s[4 * 33], s[5 * 33]); o.w = pk2(s[6 * 33], s[7 * 33]);
        int nr = n;
        if (perm16) { const int cc = (n0 + n) & 255;
            nr = (((cc >> 3) & 1) << 7) + ((cc >> 6) << 5) + (((cc >> 4) & 3) << 3) + (cc & 7) - (n0 & 255); }
        if (fp8) {
            v2u o8; o8.x = (unsigned)__builtin_amdgcn_cvt_pk_fp8_f32(s[2 * 33] * SW8, s[3 * 33] * SW8, __builtin_amdgcn_cvt_pk_fp8_f32(s[0 * 33] * SW8, s[1 * 33] * SW8, 0, false), true);
            o8.y = (unsigned)__builtin_amdgcn_cvt_pk_fp8_f32(s[6 * 33] * SW8, s[7 * 33] * SW8, __builtin_amdgcn_cvt_pk_fp8_f32(s[4 * 33] * SW8, s[5 * 33] * SW8, 0, false), true);
            *(v2u*)((unsigned char*)dst + (ptrdiff_t)nr * Kd + 8 * c) = o8;
        } else *(v4u*)(dst + (ptrdiff_t)nr * Kd + 8 * c) = o; }
    LDS_FENCE();
}

struct Ptrs {
    const float *x, *p, *norm1_g, *w_in, *four_w, *gmlp_ln_g, *gmlp_ln_b, *gmlp_ws, *gmlp_bs, *conv_w, *gate_b, *mnorm_g, *w_out, *norm2_g, *router_w, *router_b,
                *ew_gate, *ew_up, *ew_down, *sh_gate, *sh_up, *sh_down, *ple_w_in, *ple_w_gate, *ple_norm_g, *final_g;
    float* out; unsigned char* ws;
};
typedef const __attribute__((address_space(4))) unsigned char* kptr_t;
__device__ __forceinline__ void load_ptrs(Ptrs& P) {
    kptr_t k = (kptr_t)__builtin_amdgcn_kernarg_segment_ptr(); asm volatile("" : "+s"(k));
#define KP(i) (*(const float* const __attribute__((address_space(4)))*)(k + 8 * (i)))
    P.x = KP(0); P.p = KP(1); P.norm1_g = KP(2); P.w_in = KP(3); P.four_w = KP(4); P.gmlp_ln_g = KP(5); P.gmlp_ln_b = KP(6); P.gmlp_ws = KP(7); P.gmlp_bs = KP(8);
    P.conv_w = KP(9); P.gate_b = KP(10); P.mnorm_g = KP(11); P.w_out = KP(12); P.norm2_g = KP(13); P.router_w = KP(14); P.router_b = KP(15);
    P.ew_gate = KP(16); P.ew_up = KP(17); P.ew_down = KP(18); P.sh_gate = KP(19); P.sh_up = KP(20); P.sh_down = KP(21); P.ple_w_in = KP(22); P.ple_w_gate = KP(23);
    P.ple_norm_g = KP(24); P.final_g = KP(25); P.out = (float*)KP(26); P.ws = (unsigned char*)KP(27);
#undef KP
}

__device__ __forceinline__ void phase_p0a(const Ptrs& P, LAS unsigned char* lds, int tid_, int vcu, int G) {
    const int tid = otid(); (void)tid_;
    const int lane = tid & 63, wave = tid >> 6;
    LAS float* scr = (LAS float*)(lds + wave * 16384);
    const int gw = vcu * NWAVES + wave, NGW = G * NWAVES;
    constexpr int NI_WIN = 1024, NI_WOUT = 512, NI_ROUT = 64, NI_PLEIN = 128, NI_PLEG = 512, NI_SH = 384, NI_EXP = 128 * 384, NI_L = NI_WIN + NI_WOUT + NI_ROUT + NI_PLEIN + NI_PLEG + NI_SH + NI_EXP;
    for (int it = gw; it < NL * NI_L; it += NGW) {
        const int l = NL - 1 - it / NI_L; int r = it % NI_L;
        if (r >= NI_L - NI_EXP - NI_SH) {
            r -= NI_L - NI_EXP - NI_SH;
            int eidx, q; const float *sg, *su, *sd;
            if (r < NI_SH) { eidx = 0; q = r; sg = P.sh_gate + (size_t)l * 1024 * 256; su = P.sh_up + (size_t)l * 1024 * 256; sd = P.sh_down + (size_t)l * 256 * 1024; }
            else { r -= NI_SH; const int e = r / 384; q = r % 384; eidx = 1 + e; const size_t eo = ((size_t)l * NE + e) * 1024 * 256; sg = P.ew_gate + eo; su = P.ew_up + eo; sd = P.ew_down + eo; }
            if (q < 256) { const int up = q >> 7, qq = q & 127, kb = qq >> 3, nb = qq & 7, n0 = 32 * nb, k0 = 64 * kb;
                if (eidx) {
                    unsigned char* d8 = P.ws + WS_WGU + (size_t)l * WGU_L + ((size_t)(eidx - 1) * 512 + 256 * (n0 >> 7) + (n0 & 127) + 128 * up) * 1024 + k0;
                    transpose_item(up ? su : sg, 256, k0, n0, (bf16*)d8, 1024, scr, lane, 0, 1);
                } else {
                    bf16* dst = (bf16*)(P.ws + WS_RS + (size_t)l * RS_L) + (size_t)256 * 1024 + ((size_t)256 * (n0 >> 7) + (n0 & 127) + 128 * up) * 1024 + k0;
                    transpose_item(up ? su : sg, 256, k0, n0, dst, 1024, scr, lane); } }
            else { const int qq = q - 256, kb = qq >> 5, nb = qq & 31, n0 = 32 * nb, k0 = 64 * kb;
                if (eidx) { unsigned char* d8 = P.ws + WS_WD + (size_t)l * WD_L + WD8_OFF + ((size_t)(eidx - 1) * 1024 + n0) * 256 + k0;
                    transpose_item(sd, 1024, k0, n0, (bf16*)d8, 256, scr, lane, 1, 1); }
                else { bf16* dst = (bf16*)(P.ws + WS_WD + (size_t)l * WD_L) + (size_t)n0 * 256 + k0; transpose_item(sd, 1024, k0, n0, dst, 256, scr, lane, 0); } }
            continue;
        }
        if (r < NI_WIN) { const int kb = r >> 6, nb = r & 63;
            transpose_item(P.w_in + (size_t)l * 1024 * DIN, DIN, 64 * kb, 256 + 32 * nb, (bf16*)(P.ws + WS_WIN) + ((size_t)l * 2048 + 32 * nb) * 1024 + 64 * kb, 1024, scr, lane); continue; }
        r -= NI_WIN;
        if (r < NI_WOUT) { const int kb = r >> 5, nb = r & 31;
            transpose_item(P.w_out + (size_t)l * 1024 * 1024, 1024, 64 * kb, 32 * nb, (bf16*)(P.ws + WS_WOUT) + ((size_t)l * 1024 + 32 * nb) * 1024 + 64 * kb, 1024, scr, lane); continue; }
        r -= NI_WOUT;
        if (r < NI_ROUT) { const int kb = r >> 2, nb = r & 3;
            transpose_item(P.router_w + (size_t)l * 1024 * 128, 128, 64 * kb, 32 * nb, (bf16*)(P.ws + WS_RS + (size_t)l * RS_L) + ((size_t)32 * nb) * 1024 + 64 * kb, 1024, scr, lane); continue; }
        r -= NI_ROUT;
        if (r < NI_PLEIN) { const int kb = r >> 5, nb = r & 31;
            transpose_item(P.ple_w_in + (size_t)l * 256 * 1024, 1024, 64 * kb, 32 * nb, (bf16*)(P.ws + WS_PLEIN) + ((size_t)l * 1024 + 32 * nb) * 256 + 64 * kb, 256, scr, lane); continue; }
        r -= NI_PLEIN;
        { const int kb = r >> 5, nb = r & 31;
            transpose_item(P.ple_w_gate + (size_t)l * 1024 * 1024, 1024, 64 * kb, 32 * nb, (bf16*)(P.ws + WS_PLEG) + ((size_t)l * 1024 + 32 * nb) * 1024 + 64 * kb, 1024, scr, lane); }
    }
    const size_t gt = (size_t)vcu * NTHR + tid, NGT = (size_t)G * NTHR;
    for (size_t i = gt; i < (size_t)NL * 128 * 1024 / 8; i += NGT) { const size_t l = i / (128 * 128), r = i % (128 * 128); *(v4u*)((bf16*)(P.ws + WS_RS + l * RS_L) + (size_t)128 * 1024 + r * 8) = (v4u){0u, 0u, 0u, 0u}; }
    for (size_t i = gt; i < (size_t)NL * 4 * 128 * 128 / 2; i += NGT) { const float a = P.gmlp_ws[2 * i], b = P.gmlp_ws[2 * i + 1]; ((unsigned*)(P.ws + WS_GWS))[i] = pk2(a, b); }
    for (size_t i = gt; i < (size_t)2048 * 2048 / 8; i += NGT) { const int so = (int)(i >> 8), k8 = (int)(i & 255) * 8; float v[8];
#pragma unroll
        for (int j = 0; j < 8; ++j) { const int kk = k8 + j, sx = kk & 1023; const int mm = (so * sx) & 2047; const float ang = (float)mm * (1.0f / 1024.0f);
            v[j] = (kk < 1024) ? cospif(ang) : ((kk == 1024) ? ((so & 1) ? -1.f : 1.f) : -sinpif(ang)); }
        v4u w; w.x = pk2(v[0], v[1]); w.y = pk2(v[2], v[3]); w.z = pk2(v[4], v[5]); w.w = pk2(v[6], v[7]); ((v4u*)(P.ws + WS_DFT))[i] = w; }
    for (size_t i = gt; i < (size_t)NL * T * 256 / 8; i += NGT) { const f32x4 a = __builtin_nontemporal_load((const f32x4*)P.p + 2 * i), b = __builtin_nontemporal_load((const f32x4*)P.p + 2 * i + 1);
        v4u w; w.x = pk2(a[0], a[1]); w.y = pk2(a[2], a[3]); w.z = pk2(b[0], b[1]); w.w = pk2(b[2], b[3]); ((v4u*)(P.ws + WS_PB))[i] = w; }
    for (size_t i = gt; i < (size_t)NL * 2 * 4 * 64 * 64; i += NGT) { const int e = (int)(i & 63), d = (int)((i >> 6) & 63), h = (int)((i >> 12) & 3), kind = (int)((i >> 14) & 1), l = (int)(i >> 15);
        const float* fw = P.four_w + ((size_t)(l * 4 + h) * 64) * 64 + e; float s = 0.f;
        for (int kp = 0; kp < 64; ++kp) { const float ang = (float)((kp * d) & 63) * (1.0f / 32.0f); s += (kind ? sinpif(ang) : cospif(ang)) * fw[kp * 64]; }
        ((float*)(P.ws + WS_CSW))[i] = s * 0.00276213586f; }
}

__device__ __forceinline__ void phase_p0b_fold(const Ptrs& P, LAS unsigned char* lds, int tid_, int vcu, int G) {
    const int tid = otid(); (void)tid_;
    LAS float* cs = (LAS float*)lds;
    for (int item = vcu; item < NL * 2 * 4 * 4 * 2; item += G) {
        const int ih = item & 1, eg = (item >> 1) & 3, h = (item >> 3) & 3, kind = (item >> 5) & 1, l = item >> 6;
        const float* csg = (const float*)(P.ws + WS_CSW) + ((size_t)((l * 2 + kind) * 4 + h) * 64) * 64 + eg * 16;
        __syncthreads();
        for (int q = tid; q < 1024; q += NTHR) cs[q] = csg[(q >> 4) * 64 + (q & 15)];
        __syncthreads();
        const int i = ih * 512 + tid;
        const float* wr = P.w_in + ((size_t)l * 1024 + i) * DIN + h * 64;
        float acc[16];
#pragma unroll
        for (int e = 0; e < 16; ++e) acc[e] = 0.f;
#pragma unroll 4
        for (int d4 = 0; d4 < 16; ++d4) { const f32x4 xv = *(const f32x4*)(wr + 4 * d4);
#pragma unroll
            for (int dd = 0; dd < 4; ++dd) { const LAS f32x4* cr = (const LAS f32x4*)(cs + (4 * d4 + dd) * 16);
#pragma unroll
                for (int e4 = 0; e4 < 4; ++e4) { const f32x4 c = cr[e4]; acc[4 * e4] += xv[dd] * c[0]; acc[4 * e4 + 1] += xv[dd] * c[1]; acc[4 * e4 + 2] += xv[dd] * c[2]; acc[4 * e4 + 3] += xv[dd] * c[3]; } } }
        bf16* dst = (bf16*)(P.ws + WS_WPQ) + ((size_t)l * 512 + kind * 256 + h * 64 + eg * 16) * 1024 + i;
#pragma unroll
        for (int e = 0; e < 16; ++e) dst[(size_t)e * 1024] = (bf16)f2bf(acc[e]);
    }
    __syncthreads();
}

template <int MODE>
__device__ __forceinline__ void phase_rowpass1(const Ptrs& P, LAS unsigned char* lds, int layer, int tid_, int vcu, int G) {
    const int tid = otid(); (void)tid_;
    const int lane = tid & 63, wave = tid >> 6, gw = vcu * NWAVES + wave, NGW = G * NWAVES;
    LAS float* gwt = (LAS float*)lds;
    if (MODE != 2) {
        for (int idx = tid; idx < 4096; idx += NTHR) { const int k = idx >> 2, q = idx & 3; const f32x4 v = *(const f32x4*)(P.w_in + ((size_t)layer * 1024 + k) * DIN + 2304 + 4 * q);
            gwt[(4 * q + 0) * 1024 + k] = v[0]; gwt[(4 * q + 1) * 1024 + k] = v[1]; gwt[(4 * q + 2) * 1024 + k] = v[2]; gwt[(4 * q + 3) * 1024 + k] = v[3]; }
        __syncthreads();
    }
    float* H = (float*)(P.ws + WS_H); const bf16* GE = (const bf16*)(P.ws + WS_GE);
    const float* pg = P.ple_norm_g + (size_t)(layer - 1) * D;
    const float* g1 = (MODE == 2) ? P.final_g : P.norm1_g + (size_t)layer * D;
    for (int row = gw; row < T; row += NGW) {
        f32x4 v[4];
        if (MODE == 0) {
#pragma unroll
            for (int j = 0; j < 4; ++j) v[j] = ((const f32x4*)(P.x + (size_t)row * D))[lane + 64 * j];
        } else {
            f32x4 e[4]; float ss = 0.f;
#pragma unroll
            for (int j = 0; j < 4; ++j) { v[j] = ((const f32x4*)(H + (size_t)row * D))[lane + 64 * j]; const v2u w = __builtin_nontemporal_load((const v2u*)(GE + (size_t)row * D) + lane + 64 * j);
                e[j] = (f32x4){bflo(w.x), bfhi(w.x), bflo(w.y), bfhi(w.y)}; ss += e[j][0] * e[j][0] + e[j][1] * e[j][1] + e[j][2] * e[j][2] + e[j][3] * e[j][3]; }
            const float r = rsqrtf(wave_sum(ss) * (1.f / D) + EPS);
#pragma unroll
            for (int j = 0; j < 4; ++j) { const f32x4 g = ((const f32x4*)pg)[lane + 64 * j]; v[j] = v[j] + e[j] * r * g; }
        }
        if (MODE != 2) {
#pragma unroll
            for (int j = 0; j < 4; ++j) ((f32x4*)(H + (size_t)row * D))[lane + 64 * j] = v[j];
        }
        float ss = 0.f;
#pragma unroll
        for (int j = 0; j < 4; ++j) ss += v[j][0] * v[j][0] + v[j][1] * v[j][1] + v[j][2] * v[j][2] + v[j][3] * v[j][3];
        const float rstd = rsqrtf(wave_sum(ss) * (1.f / D) + EPS);
#pragma unroll
        for (int j = 0; j < 4; ++j) { const f32x4 g = ((const f32x4*)g1)[lane + 64 * j]; v[j] = v[j] * rstd * g; }
        if (MODE == 2) {
#pragma unroll
            for (int j = 0; j < 4; ++j) ((f32x4*)(P.out + (size_t)row * D))[lane + 64 * j] = v[j];
        } else {
            bf16* A = (bf16*)(P.ws + WS_XM) + (size_t)row * D;
#pragma unroll
            for (int j = 0; j < 4; ++j) { v2u w; w.x = pk2(v[j][0], v[j][1]); w.y = pk2(v[j][2], v[j][3]); ((v2u*)A)[lane + 64 * j] = w; }
            float pg[16];
#pragma unroll
            for (int g = 0; g < 16; ++g) { float s = 0.f;
#pragma unroll
                for (int j = 0; j < 4; ++j) { const f32x4 w = *(const LAS f32x4*)(gwt + g * 1024 + 4 * (lane + 64 * j)); s += v[j][0] * w[0] + v[j][1] * w[1] + v[j][2] * w[2] + v[j][3] * w[3]; }
                pg[g] = s; }
            float p8[8], p4[4], p2[2], p1;
            { const bool hi = (lane & 32) != 0;
#pragma unroll
              for (int i = 0; i < 8; ++i) { const float send = hi ? pg[i] : pg[8 + i], keep = hi ? pg[8 + i] : pg[i]; p8[i] = keep + __shfl_xor(send, 32); } }
            { const bool hi = (lane & 16) != 0;
#pragma unroll
              for (int i = 0; i < 4; ++i) { const float send = hi ? p8[i] : p8[4 + i], keep = hi ? p8[4 + i] : p8[i]; p4[i] = keep + __shfl_xor(send, 16); } }
            { const bool hi = (lane & 8) != 0;
#pragma unroll
              for (int i = 0; i < 2; ++i) { const float send = hi ? p4[i] : p4[2 + i], keep = hi ? p4[2 + i] : p4[i]; p2[i] = keep + __shfl_xor(send, 8); } }
            { const bool hi = (lane & 4) != 0; const float send = hi ? p2[0] : p2[1], keep = hi ? p2[1] : p2[0]; p1 = keep + __shfl_xor(send, 4); }
            p1 += __shfl_xor(p1, 2); p1 += __shfl_xor(p1, 1);
            const int src = (((lane >> 3) & 1) << 5) | (((lane >> 2) & 1) << 4) | (((lane >> 1) & 1) << 3) | ((lane & 1) << 2);
            const float mine = __shfl(p1, src);
            if (lane < 16) { float gv = mine + P.gate_b[layer * 16 + lane]; if ((lane >> 2) & 1) gv = logsigf_(gv); ((float*)(P.ws + WS_GATES))[(size_t)row * 16 + lane] = gv; }
        }
    }
}
__device__ __forceinline__ void phase_rowpass2(const Ptrs& P, int layer, int tid_, int vcu, int G) {
    const int tid = otid(); (void)tid_;
    const int lane = tid & 63, wave = tid >> 6, gw = vcu * NWAVES + wave, NGW = G * NWAVES;
    const float* H = (const float*)(P.ws + WS_H); const float* g2 = P.norm2_g + (size_t)layer * D;
    for (int row = gw; row < T; row += NGW) {
        f32x4 v[4]; float ss = 0.f;
#pragma unroll
        for (int j = 0; j < 4; ++j) { v[j] = ((const f32x4*)(H + (size_t)row * D))[lane + 64 * j]; ss += v[j][0] * v[j][0] + v[j][1] * v[j][1] + v[j][2] * v[j][2] + v[j][3] * v[j][3]; }
        const float rstd = rsqrtf(wave_sum(ss) * (1.f / D) + EPS);
        bf16* A = (bf16*)(P.ws + WS_XM) + (size_t)row * D;
#pragma unroll
        for (int j = 0; j < 4; ++j) { const f32x4 g = ((const f32x4*)g2)[lane + 64 * j]; const float x0 = v[j][0] * rstd * g[0], x1 = v[j][1] * rstd * g[1], x2 = v[j][2] * rstd * g[2], x3 = v[j][3] * rstd * g[3];
            v2u w; w.x = pk2(x0, x1); w.y = pk2(x2, x3); ((v2u*)A)[lane + 64 * j] = w;
            ((unsigned*)(P.ws + WS_XM8 + (size_t)row * D))[lane + 64 * j] = (unsigned)__builtin_amdgcn_cvt_pk_fp8_f32(x2 * SX8, x3 * SX8, __builtin_amdgcn_cvt_pk_fp8_f32(x0 * SX8, x1 * SX8, 0, false), true); }
    }
}
__device__ __forceinline__ void phase_combine(const Ptrs& P, int tid_, int vcu, int G) {
    const int tid = otid(); (void)tid_;
    const int lane = tid & 63, wave = tid >> 6, gw = vcu * NWAVES + wave, NGW = G * NWAVES;
    float* H = (float*)(P.ws + WS_H); const bf16* YS = (const bf16*)(P.ws + WS_Y); const unsigned char* Y8 = (const unsigned char*)(P.ws + WS_Y) + (size_t)T * 1024 * 2; bf16* HB = (bf16*)(P.ws + WS_HB);
    const float* tg = (const float*)(P.ws + WS_TOPK);
    for (int t = gw; t < T; t += NGW) {
        float v[16]; v4u ys[2], yk[8];
        const f32x4* hp = (const f32x4*)(H + (size_t)t * D) + 4 * lane; const v4u* ysp = (const v4u*)(YS + (size_t)t * D) + 2 * lane; const v4u* yr = (const v4u*)(Y8 + (size_t)t * 8 * 1024) + lane;
        float mg = 0.f; if (lane < 8) mg = tg[(size_t)t * 8 + lane] * (1.f / 16.f);
#pragma unroll
        for (int q = 0; q < 4; ++q) { const f32x4 a = hp[q]; v[4 * q] = a[0]; v[4 * q + 1] = a[1]; v[4 * q + 2] = a[2]; v[4 * q + 3] = a[3]; }
        ys[0] = __builtin_nontemporal_load(ysp); ys[1] = __builtin_nontemporal_load(ysp + 1);
#pragma unroll
        for (int k = 0; k < 8; ++k) yk[k] = __builtin_nontemporal_load(yr + k * 64);
#pragma unroll
        for (int jj = 0; jj < 2; ++jj) { const unsigned w[4] = {ys[jj].x, ys[jj].y, ys[jj].z, ys[jj].w};
#pragma unroll
            for (int i = 0; i < 4; ++i) { v[8 * jj + 2 * i] += bflo(w[i]); v[8 * jj + 2 * i + 1] += bfhi(w[i]); } }
#pragma unroll
        for (int k = 0; k < 8; ++k) { const float g = __shfl(mg, k); const unsigned w[4] = {yk[k].x, yk[k].y, yk[k].z, yk[k].w};
#pragma unroll
            for (int i = 0; i < 4; ++i) { const auto lo = __builtin_amdgcn_cvt_pk_f32_fp8((int)w[i], false); const auto hi = __builtin_amdgcn_cvt_pk_f32_fp8((int)w[i], true);
                v[4 * i] += g * lo[0]; v[4 * i + 1] += g * lo[1]; v[4 * i + 2] += g * hi[0]; v[4 * i + 3] += g * hi[1]; } }
        f32x4* ho = (f32x4*)(H + (size_t)t * D) + 4 * lane;
#pragma unroll
        for (int q = 0; q < 4; ++q) ho[q] = (f32x4){v[4 * q], v[4 * q + 1], v[4 * q + 2], v[4 * q + 3]};
        v4u w0, w1; w0.x = pk2(v[0], v[1]); w0.y = pk2(v[2], v[3]); w0.z = pk2(v[4], v[5]); w0.w = pk2(v[6], v[7]); w1.x = pk2(v[8], v[9]); w1.y = pk2(v[10], v[11]); w1.z = pk2(v[12], v[13]); w1.w = pk2(v[14], v[15]);
        v4u* hbo = (v4u*)(HB + (size_t)t * D) + 2 * lane; hbo[0] = w0; hbo[1] = w1;
    }
}

struct ZR6 { v4u c0, c1, p0, p1, n0, n1; };
__device__ __forceinline__ ZR6 conv_load(const bf16* z, int trow, int sg, int zcol) {
    const bf16* zr = z + (size_t)trow * 2048 + zcol; ZR6 r;
    r.c0 = *(const v4u*)zr; r.c1 = *(const v4u*)(zr + 8); r.p0 = (v4u){0u, 0u, 0u, 0u}; r.p1 = r.p0; r.n0 = r.p0; r.n1 = r.p0;
    if (sg > 0) { r.p0 = *(const v4u*)(zr - 2048); r.p1 = *(const v4u*)(zr - 2048 + 8); }
    if (sg < SEQ - 1) { r.n0 = *(const v4u*)(zr + 2048); r.n1 = *(const v4u*)(zr + 2048 + 8); }
    return r;
}
__device__ __forceinline__ void conv_compute(const ZR6& r, const float* cw, int wcol, float (&o)[16]) {
    const unsigned pw[8] = {r.p0.x, r.p0.y, r.p0.z, r.p0.w, r.p1.x, r.p1.y, r.p1.z, r.p1.w}, cwd[8] = {r.c0.x, r.c0.y, r.c0.z, r.c0.w, r.c1.x, r.c1.y, r.c1.z, r.c1.w}, nw[8] = {r.n0.x, r.n0.y, r.n0.z, r.n0.w, r.n1.x, r.n1.y, r.n1.z, r.n1.w};
    float w0[16], w1[16], w2[16];
#pragma unroll
    for (int q = 0; q < 4; ++q) { const f32x4 a0 = *(const f32x4*)(cw + wcol + 4 * q), a1 = *(const f32x4*)(cw + 512 + wcol + 4 * q), a2 = *(const f32x4*)(cw + 1024 + wcol + 4 * q);
#pragma unroll
        for (int j = 0; j < 4; ++j) { w0[4 * q + j] = a0[j]; w1[4 * q + j] = a1[j]; w2[4 * q + j] = a2[j]; } }
#pragma unroll
    for (int i = 0; i < 8; ++i) {
        o[2 * i] = siluf_(w0[2 * i] * bflo(pw[i]) + w1[2 * i] * bflo(cwd[i]) + w2[2 * i] * bflo(nw[i]));
        o[2 * i + 1] = siluf_(w0[2 * i + 1] * bfhi(pw[i]) + w1[2 * i + 1] * bfhi(cwd[i]) + w2[2 * i + 1] * bfhi(nw[i])); }
}
__device__ __forceinline__ void conv16(const bf16* z, const float* cw, int trow, int sg, int zcol, int wcol, float (&o)[16]) { const ZR6 r = conv_load(z, trow, sg, zcol); conv_compute(r, cw, wcol, o); }
struct VR4 { v4u q[4]; };
__device__ __forceinline__ VR4 vT_load(const bf16* z, int t0, int hh, int tid) { const int s = tid >> 2, part = tid & 3; const bf16* src = z + (size_t)(t0 + s) * 2048 + 1024 + hh * 128 + part * 32; VR4 r;
#pragma unroll
    for (int q = 0; q < 4; ++q) r.q[q] = *(const v4u*)(src + 8 * q);
    return r; }
__device__ __forceinline__ void vT_store(LAS unsigned char* VT, const VR4& r, int tid) { const int s = tid >> 2, part = tid & 3;
#pragma unroll
    for (int q = 0; q < 4; ++q) { const unsigned ww[4] = {r.q[q].x, r.q[q].y, r.q[q].z, r.q[q].w};
#pragma unroll
        for (int i = 0; i < 4; ++i) { const int e = part * 32 + q * 8 + 2 * i; *(LAS bf16*)(VT + e * 272 + s * 2) = (bf16)(ww[i] & 0xffffu); *(LAS bf16*)(VT + (e + 1) * 272 + s * 2) = (bf16)(ww[i] >> 16); } } }
__device__ __forceinline__ void stage_vT(LAS unsigned char* VT, const bf16* z, int t0, int hh, int tid) {
    const int s = tid >> 2, part = tid & 3; const bf16* src = z + (size_t)(t0 + s) * 2048 + 1024 + hh * 128 + part * 32;
#pragma unroll
    for (int q = 0; q < 4; ++q) { const v4u w = *(const v4u*)(src + 8 * q); const unsigned ww[4] = {w.x, w.y, w.z, w.w};
#pragma unroll
        for (int i = 0; i < 4; ++i) { const int e = part * 32 + q * 8 + 2 * i; *(LAS bf16*)(VT + e * 272 + s * 2) = (bf16)(ww[i] & 0xffffu); *(LAS bf16*)(VT + (e + 1) * 272 + s * 2) = (bf16)(ww[i] >> 16); } }
}


__device__ __forceinline__ float shfl_up_l(float v, int off, int lane) { return __int_as_float(__builtin_amdgcn_ds_bpermute(((lane - off) & 63) << 2, __float_as_int(v))); }
__device__ __forceinline__ float shfl_l(float v, int src) { return __int_as_float(__builtin_amdgcn_ds_bpermute(src << 2, __float_as_int(v))); }
__device__ __forceinline__ void gate_scan(const LAS float* li, LAS float* lf, int dir, int lane, int (&pos)[2], float (&b)[2], float (&x)[2], float& g) {
    pos[0] = dir ? 127 - 2 * lane : 2 * lane; pos[1] = dir ? 126 - 2 * lane : 2 * lane + 1;
    const float f0 = lf[pos[0]], f1 = lf[pos[1]]; const float s1 = f0 + f1; float inc = s1;
#pragma unroll
    for (int off = 1; off < 64; off <<= 1) { const float y = shfl_up_l(inc, off, lane); if (lane >= off) inc += y; }
    const float exc = inc - s1; b[0] = exc + f0; b[1] = exc + s1; g = shfl_l(inc, 63);
    lf[pos[0]] = b[0]; lf[pos[1]] = b[1];
    x[0] = li[pos[0]] - b[0]; x[1] = li[pos[1]] - b[1];
}

__device__ __forceinline__ void m1_unit(LAS unsigned char* L, int u, const bf16* z, const float* gates, const float* cw, float* cloc, float* nloc, float* mg, int tid_) {
    const int tid = otid(); (void)tid_;
    constexpr int VT = 0, KWF = 34816, KWB = 52224, GA = 69632;
    const int lane = tid & 63, w = tid >> 6, fr = lane & 15, fq = lane >> 4;
    const int c = u & 15, hh = (u >> 4) & 3, b = u >> 6, t0 = b * SEQ + c * 128;
    LAS float* ga = (LAS float*)(L + GA);
    const VR4 vr = vT_load(z, t0, hh, tid);
    const ZR6 zk = conv_load(z, t0 + (tid >> 2), c * 128 + (tid >> 2), 768 + hh * 64 + (tid & 3) * 16);
    if (tid < 128) { const float* g = gates + (size_t)(t0 + tid) * 16; ga[tid] = g[hh]; ga[128 + tid] = g[4 + hh]; ga[256 + tid] = g[8 + hh]; ga[384 + tid] = g[12 + hh]; }
    vT_store(L + VT, vr, tid);
    __syncthreads();
    if (w < 2) {
        const int dir = w; LAS float* li = ga + dir * 256; LAS float* lf = li + 128; LAS float* wo = ga + 512 + dir * 128;
        int pos[2]; float bq[2], xq[2], g; gate_scan(li, lf, dir, lane, pos, bq, xq, g);
        float a0 = g + xq[0], a1 = g + xq[1], m = fmaxf(a0, a1);
#pragma unroll
        for (int off = 1; off < 64; off <<= 1) m = fmaxf(m, __shfl_xor(m, off));
        wo[pos[0]] = __expf(a0 - m); wo[pos[1]] = __expf(a1 - m);
        if (lane == 0) { mg[((size_t)dir * 512 + u) * 2 + 0] = m; mg[((size_t)dir * 512 + u) * 2 + 1] = g; }
    }
    __syncthreads();
    { const int s = tid >> 2, part = tid & 3; float k[16]; conv_compute(zk, cw, 256 + hh * 64 + part * 16, k);
      const float wF = ga[512 + s], wB = ga[640 + s];
#pragma unroll
      for (int i = 0; i < 16; ++i) { const int d = part * 16 + i; *(LAS bf16*)(L + KWF + d * 272 + s * 2) = (bf16)f2bf(wF * k[i]); *(LAS bf16*)(L + KWB + d * 272 + s * 2) = (bf16)f2bf(wB * k[i]); } }
    __syncthreads();
    { const int dir = w >> 2, wq = w & 3; LAS unsigned char* KW = L + (dir ? KWB : KWF);
      f32x4 acc[2][4];
#pragma unroll
      for (int mt = 0; mt < 2; ++mt)
#pragma unroll
          for (int nt = 0; nt < 4; ++nt) acc[mt][nt] = (f32x4){0.f, 0.f, 0.f, 0.f};
#pragma unroll
      for (int ks = 0; ks < 4; ++ks) { bf16x8 a[2];
#pragma unroll
          for (int mt = 0; mt < 2; ++mt) a[mt] = *(const LAS bf16x8*)(L + VT + (32 * wq + mt * 16 + fr) * 272 + ks * 64 + fq * 16);
#pragma unroll
          for (int nt = 0; nt < 4; ++nt) { const bf16x8 bk = *(const LAS bf16x8*)(KW + (nt * 16 + fr) * 272 + ks * 64 + fq * 16);
#pragma unroll
              for (int mt = 0; mt < 2; ++mt) acc[mt][nt] = MFMA16(a[mt], bk, acc[mt][nt]); } }
      float* co = cloc + ((size_t)dir * 512 + u) * 8192;
#pragma unroll
      for (int mt = 0; mt < 2; ++mt)
#pragma unroll
          for (int nt = 0; nt < 4; ++nt)
#pragma unroll
              for (int r = 0; r < 4; ++r) co[(32 * wq + mt * 16 + 4 * fq + r) * 64 + nt * 16 + fr] = acc[mt][nt][r]; }
    if (tid < 128) { const int dir = tid >> 6, d = tid & 63; const LAS unsigned char* KW = L + (dir ? KWB : KWF) + d * 272; float s = 0.f;
        for (int q = 0; q < 16; ++q) { const v4u w4 = *(const LAS v4u*)(KW + q * 16); s += bflo(w4.x) + bfhi(w4.x) + bflo(w4.y) + bfhi(w4.y) + bflo(w4.z) + bfhi(w4.z) + bflo(w4.w) + bfhi(w4.w); }
        nloc[((size_t)dir * 512 + u) * 64 + d] = s; }
    __syncthreads();
}

__device__ __forceinline__ void phase_m2(const Ptrs& P, int tid_, int vcu, int G) {
    const int tid = otid(); (void)tid_;
    const float* cloc = (const float*)(P.ws + WS_CLOC); bf16* cprev = (bf16*)(P.ws + WS_CPREV);
    float* sm = (float*)(P.ws + WS_SMALL); const float* nloc = sm; float* nprev = sm + 65536; const float* mg = sm + 131072; float* mprev = sm + 131072 + 2048;
    for (int it = vcu; it < 64 * 17; it += G) {
        const int seq = it / 17, blk = it % 17, dir = seq >> 5, bh = seq & 31;
        if (blk == 16 && tid >= 64) continue;
        float loc[16], ml[16], gg[16];
#pragma unroll
        for (int step = 0; step < 16; ++step) {
            const int c = dir ? 15 - step : step; const size_t du = (size_t)dir * 512 + bh * 16 + c;
            ml[step] = mg[du * 2]; gg[step] = mg[du * 2 + 1];
            loc[step] = (blk < 16) ? __builtin_nontemporal_load(cloc + du * 8192 + blk * 512 + tid) : nloc[du * 64 + tid];
        }
        float m = 0.f, st = 0.f;
#pragma unroll
        for (int step = 0; step < 16; ++step) {
            const int c = dir ? 15 - step : step; const size_t du = (size_t)dir * 512 + bh * 16 + c;
            if (blk < 16) cprev[du * 8192 + blk * 512 + tid] = (bf16)f2bf(st);
            else { nprev[du * 64 + tid] = st; if (tid == 0) mprev[du] = m; }
            const float mn = fmaxf(gg[step] + m, ml[step]), ao = __expf(gg[step] + m - mn), an = __expf(ml[step] - mn);
            st = ao * st + an * loc[step]; m = mn;
        }
    }
}

__device__ __forceinline__ void phase_pqfold(const Ptrs& P, int tid_, int vcu, int G) {
    const int tid = otid(); (void)tid_;
    const bf16* PQ = (const bf16*)(P.ws + WS_PQT); bf16* PF = (bf16*)(P.ws + WS_PQF);
    const size_t gt = (size_t)vcu * NTHR + tid, NGT = (size_t)G * NTHR;
    for (size_t i = gt; i < (size_t)2048 * 2048 / 8; i += NGT) { const int row = (int)(i >> 8), k8 = (int)(i & 255) * 8; const bool sinpart = k8 >= 1024; const int s8 = k8 & 1023;
        const bf16* src = PQ + (size_t)row * 4096 + (sinpart ? 2048 : 0);
        const v4u f = *(const v4u*)(src + s8); const unsigned fw[4] = {f.x, f.y, f.z, f.w}; float v[8];
#pragma unroll
        for (int j = 0; j < 8; ++j) { const int sx = s8 + j; const float a = (j & 1) ? bfhi(fw[j >> 1]) : bflo(fw[j >> 1]); const float r = (sx > 0) ? bf2f(src[2048 - sx]) : 0.f;
            v[j] = sinpart ? ((sx > 0) ? a - r : bf2f(PQ[(size_t)row * 4096 + 1024])) : a + r; }
        v4u w; w.x = pk2(v[0], v[1]); w.y = pk2(v[2], v[3]); w.z = pk2(v[4], v[5]); w.w = pk2(v[6], v[7]); ((v4u*)PF)[i] = w; }
}

template <int DIR>
__device__ __forceinline__ void m3_dir(LAS unsigned char* L, const LAS float* ga, const f32x4 (&S)[8], const bf16x8 (&aq)[2], const bf16x8 (&cpf)[8][2], f32x4 npv, float mp, f32x4 (&acc)[8], float (&inter)[4], float (&mt)[4], float (&rs)[4], int w, int lane) {
    constexpr int QS = 0, SM = 71680;
    const int fr = lane & 15, fq = lane >> 4;
    const LAS float* li = ga + DIR * 384; const LAS float* bb = li + 128; const LAS float* pm = li + 256;
    float bj[4];
#pragma unroll
    for (int r = 0; r < 4; ++r) { const int j = 16 * w + 4 * fq + r; bj[r] = bb[j]; mt[r] = fmaxf(bj[r] + pm[j], bj[r] + mp); inter[r] = __expf(bj[r] + mp - mt[r]); rs[r] = 0.f; }
#pragma unroll
    for (int nt = 0; nt < 8; ++nt) { const int s = nt * 16 + fr; const float xs = li[s] - bb[s];
#pragma unroll
        for (int r = 0; r < 4; ++r) { const int j = 16 * w + 4 * fq + r; const bool valid = DIR ? (s >= j) : (s <= j);
            const float pv = valid ? __expf(bj[r] + xs - mt[r]) * S[nt][r] : 0.f; rs[r] += pv; *(LAS bf16*)(L + SM + j * 272 + s * 2) = (bf16)pk2(pv, 0.f); } }
#pragma unroll
    for (int r = 0; r < 4; ++r) { rs[r] += __shfl_xor(rs[r], 1); rs[r] += __shfl_xor(rs[r], 2); rs[r] += __shfl_xor(rs[r], 4); rs[r] += __shfl_xor(rs[r], 8); }
    LDS_FENCE();
#pragma unroll
    for (int nt = 0; nt < 8; ++nt) { f32x4 a = {0.f, 0.f, 0.f, 0.f};
#pragma unroll
        for (int ks = 0; ks < 2; ++ks) a = MFMA16(aq[ks], cpf[nt][ks], a);
#pragma unroll
        for (int r = 0; r < 4; ++r) a[r] *= inter[r];
        acc[nt] = a; }
    { const f32x4 np = npv;
#pragma unroll
      for (int r = 0; r < 4; ++r) { const int j = 16 * w + 4 * fq + r; const v2u qw = *(const LAS v2u*)(L + QS + j * 144 + fr * 8);
          float qn = bflo(qw.x) * np[0] + bfhi(qw.x) * np[1] + bflo(qw.y) * np[2] + bfhi(qw.y) * np[3];
          qn += __shfl_xor(qn, 1); qn += __shfl_xor(qn, 2); qn += __shfl_xor(qn, 4); qn += __shfl_xor(qn, 8);
          rs[r] = rs[r] + inter[r] * qn; } }
}
__device__ __forceinline__ void m3_pv(LAS unsigned char* L, f32x4 (&acc)[8], int w, int lane) {
    constexpr int VT = 36864, SM = 71680; const int fr = lane & 15, fq = lane >> 4;
#pragma unroll
    for (int ks = 0; ks < 4; ++ks) { const bf16x8 ap = *(const LAS bf16x8*)(L + SM + (16 * w + fr) * 272 + ks * 64 + fq * 16);
#pragma unroll
        for (int nt = 0; nt < 8; ++nt) { const bf16x8 bv = *(const LAS bf16x8*)(L + VT + (nt * 16 + fr) * 272 + ks * 64 + fq * 16); acc[nt] = MFMA16(ap, bv, acc[nt]); } }
}
__device__ __forceinline__ void m3_unit(LAS unsigned char* L, int u, const bf16* z, const float* gates, const float* cw, const bf16* cprev, const float* nprev, const float* mprev, const float* normg, bf16* mix, int tid_) {
    const int tid = otid(); (void)tid_;
    constexpr int QS = 0, KS = 18432, VT = 36864, GA = 106496;
    const int lane = tid & 63, w = tid >> 6, fr = lane & 15, fq = lane >> 4;
    const int c = u & 15, hh = (u >> 4) & 3, b = u >> 6, t0 = b * SEQ + c * 128;
    LAS float* ga = (LAS float*)(L + GA);
    const ZR6 zq = conv_load(z, t0 + (tid >> 2), c * 128 + (tid >> 2), 512 + hh * 64 + (tid & 3) * 16);
    const ZR6 zk = conv_load(z, t0 + (tid >> 2), c * 128 + (tid >> 2), 768 + hh * 64 + (tid & 3) * 16);
    const VR4 vr = vT_load(z, t0, hh, tid);
    if (tid < 128) { const float* g = gates + (size_t)(t0 + tid) * 16; ga[tid] = g[hh]; ga[128 + tid] = g[4 + hh]; ga[384 + tid] = g[8 + hh]; ga[512 + tid] = g[12 + hh]; }
    { const int s = tid >> 2, part = tid & 3; float o[16];
      conv_compute(zq, cw, hh * 64 + part * 16, o);
      v4u w0, w1; w0.x = pk2(o[0] * 0.125f, o[1] * 0.125f); w0.y = pk2(o[2] * 0.125f, o[3] * 0.125f); w0.z = pk2(o[4] * 0.125f, o[5] * 0.125f); w0.w = pk2(o[6] * 0.125f, o[7] * 0.125f);
      w1.x = pk2(o[8] * 0.125f, o[9] * 0.125f); w1.y = pk2(o[10] * 0.125f, o[11] * 0.125f); w1.z = pk2(o[12] * 0.125f, o[13] * 0.125f); w1.w = pk2(o[14] * 0.125f, o[15] * 0.125f);
      *(LAS v4u*)(L + QS + s * 144 + part * 32) = w0; *(LAS v4u*)(L + QS + s * 144 + part * 32 + 16) = w1;
      conv_compute(zk, cw, 256 + hh * 64 + part * 16, o);
      w0.x = pk2(o[0], o[1]); w0.y = pk2(o[2], o[3]); w0.z = pk2(o[4], o[5]); w0.w = pk2(o[6], o[7]); w1.x = pk2(o[8], o[9]); w1.y = pk2(o[10], o[11]); w1.z = pk2(o[12], o[13]); w1.w = pk2(o[14], o[15]);
      *(LAS v4u*)(L + KS + s * 144 + part * 32) = w0; *(LAS v4u*)(L + KS + s * 144 + part * 32 + 16) = w1; }
    vT_store(L + VT, vr, tid);
    bf16x8 cpf[8][2];
#pragma unroll
    for (int nt = 0; nt < 8; ++nt)
#pragma unroll
        for (int ks = 0; ks < 2; ++ks) cpf[nt][ks] = *(const bf16x8*)(cprev + ((size_t)u * 128 + nt * 16 + fr) * 64 + ks * 32 + fq * 8);
    f32x4 npv = *(const f32x4*)(nprev + (size_t)u * 64 + fr * 4); const float mp0 = mprev[u], mp1 = mprev[512 + u];
    __syncthreads();
    if (w < 2) {
        const int dir = w; LAS float* li = ga + dir * 384; LAS float* lf = li + 128; LAS float* pm = li + 256;
        int pos[2]; float bq[2], xq[2], g; gate_scan(li, lf, dir, lane, pos, bq, xq, g);
        const float m1 = fmaxf(xq[0], xq[1]); float inc = m1;
#pragma unroll
        for (int off = 1; off < 64; off <<= 1) { const float y = shfl_up_l(inc, off, lane); if (lane >= off) inc = fmaxf(inc, y); }
        float exc = shfl_up_l(inc, 1, lane); if (lane == 0) exc = -3.0e38f;
        pm[pos[0]] = fmaxf(exc, xq[0]); pm[pos[1]] = fmaxf(exc, m1);
    }
    __syncthreads();
    f32x4 S[8]; bf16x8 aq[2];
#pragma unroll
    for (int ks = 0; ks < 2; ++ks) aq[ks] = *(const LAS bf16x8*)(L + QS + (16 * w + fr) * 144 + ks * 64 + fq * 16);
#pragma unroll
    for (int nt = 0; nt < 8; ++nt) { f32x4 a = {0.f, 0.f, 0.f, 0.f};
#pragma unroll
        for (int ks = 0; ks < 2; ++ks) { const bf16x8 bk = *(const LAS bf16x8*)(L + KS + (nt * 16 + fr) * 144 + ks * 64 + fq * 16); a = MFMA16(aq[ks], bk, a); }
        S[nt] = a; }
    f32x4 hsum[8], acc[8]; float inter[4], mt[4], den[4];
    m3_dir<0>(L, ga, S, aq, cpf, npv, mp0, acc, inter, mt, den, w, lane);
#pragma unroll
    for (int nt = 0; nt < 8; ++nt)
#pragma unroll
        for (int ks = 0; ks < 2; ++ks) cpf[nt][ks] = *(const bf16x8*)(cprev + (((size_t)512 + u) * 128 + nt * 16 + fr) * 64 + ks * 32 + fq * 8);
    npv = *(const f32x4*)(nprev + ((size_t)512 + u) * 64 + fr * 4);
    m3_pv(L, acc, w, lane);
#pragma unroll
    for (int nt = 0; nt < 8; ++nt)
#pragma unroll
        for (int r = 0; r < 4; ++r) hsum[nt][r] = acc[nt][r] * __builtin_amdgcn_rcpf(fmaxf(fabsf(den[r]), __expf(-mt[r])));
    LDS_FENCE();
    m3_dir<1>(L, ga, S, aq, cpf, npv, mp1, acc, inter, mt, den, w, lane);
    unsigned short zo[4][8];
#pragma unroll
    for (int r = 0; r < 4; ++r)
#pragma unroll
        for (int nt = 0; nt < 8; ++nt) zo[r][nt] = z[(size_t)(t0 + 16 * w + 4 * fq + r) * 2048 + 1536 + hh * 128 + nt * 16 + fr];
    m3_pv(L, acc, w, lane);
#pragma unroll
    for (int nt = 0; nt < 8; ++nt)
#pragma unroll
        for (int r = 0; r < 4; ++r) hsum[nt][r] += acc[nt][r] * __builtin_amdgcn_rcpf(fmaxf(fabsf(den[r]), __expf(-mt[r])));
    __syncthreads();
#pragma unroll
    for (int r = 0; r < 4; ++r) { const int j = 16 * w + 4 * fq + r; const size_t t = (size_t)(t0 + j); float xv[8]; float s1 = 0.f;
#pragma unroll
        for (int nt = 0; nt < 8; ++nt) { xv[nt] = sigmoidf_(bf2f(zo[r][nt])) * hsum[nt][r]; s1 += xv[nt]; }
        s1 += __shfl_xor(s1, 1); s1 += __shfl_xor(s1, 2); s1 += __shfl_xor(s1, 4); s1 += __shfl_xor(s1, 8);
        const float mean = s1 * (1.f / 128.f); float s2 = 0.f;
#pragma unroll
        for (int nt = 0; nt < 8; ++nt) { xv[nt] -= mean; s2 += xv[nt] * xv[nt]; }
        s2 += __shfl_xor(s2, 1); s2 += __shfl_xor(s2, 2); s2 += __shfl_xor(s2, 4); s2 += __shfl_xor(s2, 8);
        const float rstd = rsqrtf(s2 * (1.f / 128.f) + EPS);
#pragma unroll
        for (int nt = 0; nt < 8; ++nt) { const int e = nt * 16 + fr; mix[t * 1024 + 512 + hh * 128 + e] = (bf16)f2bf(xv[nt] * rstd * normg[hh * 128 + e]); } }
    __syncthreads();
}

__device__ __forceinline__ void gmlp_unit(LAS unsigned char* L, int u, const bf16* z, const bf16* wsb, const float* bs, const float* lng, const float* lnb, bf16* mix, int tid_) {
    const int tid = otid(); (void)tid_;
    const int lane = tid & 63, w = tid >> 6, fr = lane & 15, fq = lane >> 4, t0 = u * 128;
    { const int j = tid >> 2, part = tid & 3; const bf16* src = z + (size_t)(t0 + j) * 2048 + 256 + part * 64; float x[64]; float s1 = 0.f;
#pragma unroll
      for (int q = 0; q < 8; ++q) { const v4u w4 = *(const v4u*)(src + 8 * q); const unsigned ww[4] = {w4.x, w4.y, w4.z, w4.w};
#pragma unroll
          for (int i = 0; i < 4; ++i) { x[q * 8 + 2 * i] = geluf_(bflo(ww[i])); x[q * 8 + 2 * i + 1] = geluf_(bfhi(ww[i])); s1 += x[q * 8 + 2 * i] + x[q * 8 + 2 * i + 1]; } }
      s1 += __shfl_xor(s1, 1); s1 += __shfl_xor(s1, 2); const float mean = s1 * (1.f / 256.f); float s2 = 0.f;
#pragma unroll
      for (int i = 0; i < 64; ++i) { x[i] -= mean; s2 += x[i] * x[i]; }
      s2 += __shfl_xor(s2, 1); s2 += __shfl_xor(s2, 2); const float rstd = rsqrtf(s2 * (1.f / 256.f) + EPS);
#pragma unroll
      for (int i = 0; i < 64; ++i) { const int col = part * 64 + i; *(LAS bf16*)(L + col * 272 + j * 2) = (bf16)f2bf(x[i] * rstd * lng[col] + lnb[col]); } }
    __syncthreads();
#pragma unroll 1
    for (int hh = 0; hh < 4; ++hh) { f32x4 acc[4];
#pragma unroll
        for (int nt = 0; nt < 4; ++nt) acc[nt] = (f32x4){0.f, 0.f, 0.f, 0.f};
#pragma unroll
        for (int ks = 0; ks < 4; ++ks) { const bf16x8 a = *(const bf16x8*)(wsb + ((size_t)(hh * 128 + 16 * w + fr) * 128 + ks * 32 + fq * 8));
#pragma unroll
            for (int nt = 0; nt < 4; ++nt) { const bf16x8 bv = *(const LAS bf16x8*)(L + (hh * 64 + nt * 16 + fr) * 272 + ks * 64 + fq * 16); acc[nt] = MFMA16(a, bv, acc[nt]); } }
#pragma unroll
        for (int nt = 0; nt < 4; ++nt)
#pragma unroll
            for (int r = 0; r < 4; ++r) { const int i = 16 * w + 4 * fq + r, d = nt * 16 + fr; const float sv = acc[nt][r] + bs[hh * 128 + i];
                const float uu = geluf_(bf2f(z[(size_t)(t0 + i) * 2048 + hh * 64 + d])); mix[(size_t)(t0 + i) * 1024 + 256 + hh * 64 + d] = (bf16)f2bf(uu * sv); } }
    __syncthreads();
}

__device__ __forceinline__ void phase_route(const Ptrs& P, LAS unsigned char* lds, int layer, int tid_, int vcu, int G) {
    const int tid = otid(); (void)tid_;
    const int lane = tid & 63, wave = tid >> 6;
    LAS int* hist = (LAS int*)lds; LAS int* base = hist + 128; LAS int* pe = hist + 256; LAS int* prank = hist + 768;
    const float* lg = (const float*)(P.ws + WS_LOGIT); const float* rb = P.router_b + layer * NE;
    float* tg = (float*)(P.ws + WS_TOPK); int* list = (int*)(P.ws + WS_LIST);
    unsigned* cursor = (unsigned*)(P.ws + WS_CTL) + CW_CNT + layer * 256;
    const float rb0 = rb[lane], rb1 = rb[64 + lane];
    for (int tb = vcu; tb < T / 64; tb += G) {
        if (tid < 128) hist[tid] = 0;
        __syncthreads();
        LAS float* wv = (LAS float*)(lds + 8192) + wave * 128; LAS float* ssel = (LAS float*)(lds + 8192 + 4096) + wave * 8;
        float nl0 = lg[(size_t)(tb * 64 + wave * 8) * 128 + lane], nl1 = lg[(size_t)(tb * 64 + wave * 8) * 128 + 64 + lane];
#pragma unroll 1
        for (int i = 0; i < 8; ++i) {
            const int t = tb * 64 + wave * 8 + i;
            const float s0 = sigmoidf_(nl0), s1 = sigmoidf_(nl1);
            if (i < 7) { nl0 = lg[(size_t)(t + 1) * 128 + lane]; nl1 = lg[(size_t)(t + 1) * 128 + 64 + lane]; }
#if MALL_WARM
            v4u pf[6];
            { const size_t gth = ((size_t)vcu * NTHR + tid) + (size_t)G * NTHR * (size_t)(i * 6);
#pragma unroll
              for (int q = 0; q < 6; ++q) { const size_t idx = gth + (size_t)G * NTHR * q;
                  const unsigned char* base = (idx < (size_t)4 * 1024 * 1024) ? (P.ws + WS_WGU + (size_t)layer * WGU_L + idx * 16) : (P.ws + WS_WD + (size_t)layer * WD_L + WD8_OFF + (idx - (size_t)4 * 1024 * 1024) * 16);
                  pf[q] = *(const v4u*)base; } }
#endif
            const float v0 = s0 + rb0, v1 = s1 + rb1;
            unsigned k0 = __float_as_uint(v0), k1 = __float_as_uint(v1);
            k0 = (k0 & 0x80000000u) ? ~k0 : (k0 | 0x80000000u); k1 = (k1 & 0x80000000u) ? ~k1 : (k1 | 0x80000000u);
            k0 = (k0 & ~127u) | (unsigned)(127 - lane); k1 = (k1 & ~127u) | (unsigned)(63 - lane);
            LAS unsigned* wk = (LAS unsigned*)wv;
            wk[lane] = k0; wk[64 + lane] = k1;
            LDS_FENCE();
            int r0 = 0, r1 = 0;
#pragma unroll 8
            for (int q = 0; q < 32; ++q) { const v4u o = *(const LAS v4u*)(wk + 4 * q);
                r0 += (o.x > k0) + (o.y > k0) + (o.z > k0) + (o.w > k0); r1 += (o.x > k1) + (o.y > k1) + (o.z > k1) + (o.w > k1); }
            const int lp0 = (wave * 8 + i) * 8;
            if (r0 < 8) { ssel[r0] = s0; pe[lp0 + r0] = lane; prank[lp0 + r0] = __hip_atomic_fetch_add(hist + lane, 1, __ATOMIC_RELAXED, __HIP_MEMORY_SCOPE_WORKGROUP); }
            if (r1 < 8) { ssel[r1] = s1; pe[lp0 + r1] = lane + 64; prank[lp0 + r1] = __hip_atomic_fetch_add(hist + lane + 64, 1, __ATOMIC_RELAXED, __HIP_MEMORY_SCOPE_WORKGROUP); }
            LDS_FENCE();
            const float sum = ((ssel[0] + ssel[1]) + (ssel[2] + ssel[3])) + ((ssel[4] + ssel[5]) + (ssel[6] + ssel[7]));
            if (lane < 8) tg[(size_t)t * 8 + lane] = ssel[lane] / sum;
            LDS_FENCE();
#if MALL_WARM
#pragma unroll
            for (int q = 0; q < 6; ++q) asm volatile("" :: "v"(pf[q].x ^ pf[q].y ^ pf[q].z ^ pf[q].w));
#endif
        }
        __syncthreads();
        if (tid < 128) { const int hc = hist[tid]; base[tid] = hc ? (int)__hip_atomic_fetch_add(cursor + tid, (unsigned)hc, __ATOMIC_RELAXED, __HIP_MEMORY_SCOPE_AGENT) : 0; }
        __syncthreads();
        { const int e = pe[tid]; list[(size_t)e * LCAP + base[e] + prank[tid]] = tb * 512 + tid; }
        __syncthreads();
    }
}
__device__ __forceinline__ void compute_blkoff(const Ptrs& P, LAS int* tbl, int layer, int tid_) {
    const int tid = otid(); (void)tid_;
    __syncthreads();
    if (tid < 128) tbl[132 + tid] = (int)__hip_atomic_load((const unsigned*)(P.ws + WS_CTL) + CW_CNT + layer * 256 + tid, __ATOMIC_RELAXED, __HIP_MEMORY_SCOPE_AGENT);
    __syncthreads();
    if (tid == 0) { int o = 0; for (int e = 0; e < 128; ++e) { tbl[e] = o; o += (tbl[132 + e] + 255) >> 8; } tbl[128] = o; }
    __syncthreads();
}

__device__ __forceinline__ int moe_prepare(const LAS int* tbl, LAS int* desc, LAS int* rowtab, const int* list, int nct, int G, int c, int pnbase) {
    const int tid = otid();
    const int total = __builtin_amdgcn_readfirstlane(tbl[128]) * nct; int n = 0;
    for (int L = c; L < total; L += G, ++n) {
        const int rb = L / nct, ct = L % nct; int lo = 0, hi = 128;
        while (hi - lo > 1) { const int mid = (lo + hi) >> 1; if (__builtin_amdgcn_readfirstlane(tbl[mid]) <= rb) lo = mid; else hi = mid; }
        const int rbl = rb - __builtin_amdgcn_readfirstlane(tbl[lo]); int nv = __builtin_amdgcn_readfirstlane(tbl[132 + lo]) - rbl * 256; nv = nv > 256 ? 256 : nv;
        if (tid < 256) rowtab[n * 256 + tid] = (tid < nv) ? list[(size_t)lo * LCAP + rbl * 256 + tid] : 0;
        if (tid == 0) { desc[3 * n] = (pnbase + lo) * nct + ct; desc[3 * n + 1] = nv; desc[3 * n + 2] = rb; }
    }
    __syncthreads();
    return n;
}

struct Args { const float* in[26]; float* out; unsigned char* ws; int ph_lo, ph_hi, li, pad; };
constexpr int N_PHASES = 2 + NL * 13 + 1;

__global__ void __launch_bounds__(NTHR, 2) mk_fwd(Args args) {
    extern __shared__ __attribute__((aligned(16))) unsigned char lds_raw[];
    LAS unsigned char* lds = (LAS unsigned char*)lds_raw;
    const int G = gridDim.x;
    const int vcu = (G % 8 == 0) ? ((int)blockIdx.x % 8) * (G / 8) + (int)blockIdx.x / 8 : (int)blockIdx.x;
    volatile LAS unsigned* MISC = (volatile LAS unsigned*)(lds + LDS_MISC);
    LAS int* blkoff = (LAS int*)(lds + LDS_TBL);
    if (threadIdx.x < 4) MISC[threadIdx.x] = 0u;
    __syncthreads();
    XcdBarrier bar; bar.bar = (unsigned*)(args.ws + WS_CTL) + CW_BAR + args.li * XCD_BAR_WORDS; bar.x = 0; bar.st = nullptr;
#if !MK_SPLIT
    bar = xcd_barrier_post((unsigned*)(args.ws + WS_CTL) + CW_BAR + args.li * XCD_BAR_WORDS, MISC);
#endif
    const int lo = args.ph_lo, hi = args.ph_hi;
#define IN(k) (lo <= (k) && (k) < hi)
#if MK_SPLIT
#define SEAM(k) do { } while (0)
#else
#define SEAM(k) do { if ((k) + 1 < hi) xcd_barrier(bar); } while (0)
#endif
#define PTRS() Ptrs P; load_ptrs(P); unsigned char* const ws = P.ws; (void)ws

    if (EN(0) && IN(0)) { PTRS(); phase_p0a(P, lds, 0, vcu, G); SEAM(0); }
    if (EN(1) && IN(1)) {
        PTRS();
        phase_p0b_fold(P, lds, 0, vcu, G);
        { pg8::Gemm g{(const bf16*)(ws + WS_PB), (const bf16*)(ws + WS_PLEIN), NL * T, NL * 1024, 256}; StackOrder S{NL, 64, 4, G, vcu};
          EpiStoreBf16 E{(bf16*)(ws + WS_E), 1024, 3}; pg8::gemm_phase<EpiStoreBf16, StackOrder, GEMM_ALIGN, GEMM_SP2>(lds, g, S, E); }
        SEAM(1);
    }
#pragma unroll 1
    for (int layer = 0; layer < NL; ++layer) {
        const int k0 = 2 + layer * 13;
        if (EN(2) && IN(k0 + 0)) { PTRS(); if (layer == 0) phase_rowpass1<0>(P, lds, layer, 0, vcu, G); else phase_rowpass1<1>(P, lds, layer, 0, vcu, G); SEAM(k0 + 0); }
        if (EN(3) && IN(k0 + 1)) {
            PTRS();
            { pg8::Gemm g{(const bf16*)(ws + WS_XM), (const bf16*)(ws + WS_WIN) + (size_t)layer * 2048 * 1024, T, 2048, 1024}; pg8::StaticOrder S; S.init(T, 2048, G, (int)blockIdx.x);
              EpiStoreBf16 E{(bf16*)(ws + WS_Z), 2048, 0xffff}; pg8::gemm_phase<EpiStoreBf16, pg8::StaticOrder, GEMM_ALIGN, GEMM_SP2>(lds, g, S, E); }
            SEAM(k0 + 1);
        }
        if (EN(4) && IN(k0 + 2)) {
            if (G == 256 ? ((int)blockIdx.x >= 128) : true) {
                PTRS();
                pg8::Gemm g{(const bf16*)(ws + WS_WPQ) + (size_t)layer * 512 * 1024, (const bf16*)(ws + WS_XM), 512, T, 1024}; pg8::StaticOrder S;
                if (G == 256) S.init(512, T, 128, (int)blockIdx.x - 128); else S.init(512, T, G, (int)blockIdx.x);
                EpiPQ E{(bf16*)(ws + WS_PQT)}; pg8::gemm_phase<EpiPQ, pg8::StaticOrder, GEMM_ALIGN, GEMM_SP2>(lds, g, S, E);
            }
            PTRS();
            for (int it = (int)blockIdx.x; it < 128 + 512; it += G) {
                if (it < 128) { if (L3MASK & 2) gmlp_unit(lds, it, (const bf16*)(ws + WS_Z), (const bf16*)(ws + WS_GWS) + (size_t)layer * 4 * 128 * 128, P.gmlp_bs + (size_t)layer * 512, P.gmlp_ln_g + (size_t)layer * 256, P.gmlp_ln_b + (size_t)layer * 256, (bf16*)(ws + WS_MIX), 0); }
                else if (L3MASK & 4) m1_unit(lds, it - 128, (const bf16*)(ws + WS_Z), (const float*)(ws + WS_GATES), P.conv_w + (size_t)layer * 3 * 512, (float*)(ws + WS_CLOC), (float*)(ws + WS_SMALL), (float*)(ws + WS_SMALL) + 131072, 0);
            }
            SEAM(k0 + 2);
        }
        if (EN(5) && IN(k0 + 3)) { PTRS(); phase_m2(P, 0, vcu, G); phase_pqfold(P, 0, vcu, G); SEAM(k0 + 3); }
        if (EN(6) && IN(k0 + 4)) {
            const int nf = (G >= 128) ? 64 : 0;
            if ((int)blockIdx.x < 64 || nf == 0) {
                PTRS();
                pg8::Gemm g{(const bf16*)(ws + WS_DFT), (const bf16*)(ws + WS_PQF), 2048, 2048, 2048}; pg8::StaticOrder S; S.init(2048, 2048, nf ? 64 : G, (int)blockIdx.x);
                EpiFourier E{(bf16*)(ws + WS_MIX)}; pg8::gemm_phase<EpiFourier, pg8::StaticOrder, GEMM_ALIGN, GEMM_SP2>(lds, g, S, E);
            }
            {
                PTRS();
                const int nm = 512 - nf;
                int u0, ustep, uend;
                if ((int)blockIdx.x < nf) { u0 = nm + (int)blockIdx.x; ustep = 512; uend = 512; } else { u0 = (int)blockIdx.x - nf; ustep = G - nf; uend = nm; }
                for (int u = u0; u < uend; u += ustep) m3_unit(lds, u, (const bf16*)(ws + WS_Z), (const float*)(ws + WS_GATES), P.conv_w + (size_t)layer * 3 * 512, (const bf16*)(ws + WS_CPREV), (const float*)(ws + WS_SMALL) + 65536, (const float*)(ws + WS_SMALL) + 131072 + 2048, P.mnorm_g + (size_t)layer * 512, (bf16*)(ws + WS_MIX), 0);
            }
            SEAM(k0 + 4);
        }
        if (EN(7) && IN(k0 + 5)) {
            PTRS();
            pg8::Gemm g{(const bf16*)(ws + WS_MIX), (const bf16*)(ws + WS_WOUT) + (size_t)layer * 1024 * 1024, T, 1024, 1024}; pg8::StaticOrder S; S.init(T, 1024, G, (int)blockIdx.x);
            EpiResid E{(float*)(ws + WS_H)}; pg8::gemm_phase<EpiResid, pg8::StaticOrder, GEMM_ALIGN, GEMM_SP2>(lds, g, S, E);
            SEAM(k0 + 5);
        }
        if (EN(8) && IN(k0 + 6)) { PTRS(); phase_rowpass2(P, layer, 0, vcu, G); SEAM(k0 + 6); }
        if (EN(9) && IN(k0 + 7)) {
            PTRS();
            pg8::Gemm g{(const bf16*)(ws + WS_XM), (const bf16*)(ws + WS_RS + (size_t)layer * RS_L), T, 768, 1024}; pg8::StaticOrder S; S.init(T, 768, G, (int)blockIdx.x);
            EpiRouterShared E{(float*)(ws + WS_LOGIT), (bf16*)(ws + WS_ACT)}; pg8::gemm_phase<EpiRouterShared, pg8::StaticOrder, GEMM_ALIGN, GEMM_SP2>(lds, g, S, E);
            SEAM(k0 + 7);
        }
        if (EN(10) && IN(k0 + 8)) { PTRS(); phase_route(P, lds, layer, 0, vcu, G); SEAM(k0 + 8); }
        if (EN(12) && IN(k0 + 9)) {
            PTRS();
            compute_blkoff(P, blkoff, layer, 0);
            LAS int* desc = (LAS int*)(lds + LDS_DESC); LAS int* rowtab = (LAS int*)(lds + LDS_ROWTAB);
            { pg8::Gemm g{(const bf16*)(ws + WS_XM8), (const bf16*)(ws + WS_WGU + (size_t)layer * WGU_L), T, 128 * 512, 1024};
              const int nun = moe_prepare(blkoff, desc, rowtab, (const int*)(ws + WS_LIST), 2, G, vcu, 0);
              stagger(vcu & 3, STAG_GU);
              MoeOrder<0> S{desc, rowtab, nun, 3, 1024u, nullptr};
              EpiSwigluScatter E{(unsigned char*)(ws + WS_ACT) + ACT8_OFF, rowtab, 1.f / (SX8 * SW8)}; pg8::gemm_phase<EpiSwigluScatter, MoeOrder<0>, GEMM_ALIGN, GEMM_SP2, true>(lds, g, S, E); }
            {
              const int n5 = (__builtin_amdgcn_readfirstlane(blkoff[128]) * 2) & 255, idx = vcu - n5;
              int st = vcu, cn = 1; if (n5 <= 128) { st = 2 * idx; cn = (idx >= 0 && idx < 128) ? 2 : 0; }
              pg8::Gemm g{(const bf16*)(ws + WS_ACT), (const bf16*)(ws + WS_WD + (size_t)layer * WD_L), T, 1024, 256}; RangeOrder S{st, cn, 4};
              EpiStoreBf16 E{(bf16*)(ws + WS_Y), 1024, 3}; pg8::gemm_phase<EpiStoreBf16, RangeOrder, GEMM_ALIGN, GEMM_SP2>(lds, g, S, E); }
            SEAM(k0 + 9);
        }
        if (EN(13) && IN(k0 + 10)) {
            PTRS();
            compute_blkoff(P, blkoff, layer, 0);
            LAS int* desc = (LAS int*)(lds + LDS_DESC); LAS int* rowtab = (LAS int*)(lds + LDS_ROWTAB);
            pg8::Gemm g{(const bf16*)(ws + WS_ACT + ACT8_OFF), (const bf16*)(ws + WS_WD + (size_t)layer * WD_L + WD8_OFF), T * 8, 128 * 1024, 256};
            const int nun = moe_prepare(blkoff, desc, rowtab, (const int*)(ws + WS_LIST), 4, G, vcu, 0);
            stagger(vcu & 3, STAG_D);
            MoeOrder<0> S{desc, rowtab, nun, 0, 256u, nullptr};
            EpiYScatter E{(unsigned char*)(ws + WS_Y) + (size_t)T * 1024 * 2, rowtab, 16.f / (SA8 * SW8)}; pg8::gemm_phase<EpiYScatter, MoeOrder<0>, GEMM_ALIGN, GEMM_SP2, true>(lds, g, S, E);
            SEAM(k0 + 10);
        }
        if (EN(14) && IN(k0 + 11)) { PTRS(); phase_combine(P, 0, vcu, G); SEAM(k0 + 11); }
        if (EN(15) && IN(k0 + 12)) {
            PTRS();
            pg8::Gemm g{(const bf16*)(ws + WS_HB), (const bf16*)(ws + WS_PLEG) + (size_t)layer * 1024 * 1024, T, 1024, 1024}; pg8::StaticOrder S; S.init(T, 1024, G, (int)blockIdx.x);
            EpiPleGate E{(bf16*)(ws + WS_GE), (const bf16*)(ws + WS_E) + (size_t)layer * T * 1024}; pg8::gemm_phase<EpiPleGate, pg8::StaticOrder, GEMM_ALIGN, GEMM_SP2>(lds, g, S, E);
            SEAM(k0 + 12);
        }
    }
    if (EN(16) && IN(N_PHASES - 1)) { PTRS(); phase_rowpass1<2>(P, lds, NL, 0, vcu, G); }
#undef IN
#undef SEAM
#undef PTRS
}

extern "C" void kernel_launch(void* const* d_in, const int* in_sizes, int n_in, void* d_out, int out_size, void* d_ws, size_t ws_size, hipStream_t stream) {
    static int grid = 0;
    if (grid == 0) {
        if (n_in != 26 || ws_size < WS_END) { fprintf(stderr, "kernel_launch: need 26 inputs and %zu bytes of workspace (got %d, %zu)\n", (size_t)WS_END, n_in, ws_size); grid = -1; return; }
        int dev = 0, cus = 0, per_cu = 0;
        if (hipGetDevice(&dev) != hipSuccess || hipDeviceGetAttribute(&cus, hipDeviceAttributeMultiprocessorCount, dev) != hipSuccess) { grid = -1; return; }
        if (hipFuncSetAttribute((const void*)mk_fwd, hipFuncAttributeMaxDynamicSharedMemorySize, LDS_BYTES) != hipSuccess) { fprintf(stderr, "kernel_launch: hipFuncSetAttribute failed\n"); grid = -1; return; }
        if (hipOccupancyMaxActiveBlocksPerMultiprocessor(&per_cu, (const void*)mk_fwd, NTHR, LDS_BYTES) != hipSuccess || per_cu < 1) fprintf(stderr, "kernel_launch: occupancy query says %d\n", per_cu);
        (void)hipGetLastError();
        grid = cus;
    }
    if (grid < 0) return;
    (void)hipMemsetAsync((char*)d_ws + WS_CTL, 0, CTL_BYTES, stream);
    Args a{};
    for (int i = 0; i < 26; ++i) a.in[i] = (const float*)d_in[i];
    a.out = (float*)d_out; a.ws = (unsigned char*)d_ws; a.pad = 0;
#if MK_SPLIT
    for (int ph = 0; ph < N_PHASES; ++ph) { a.ph_lo = ph; a.ph_hi = ph + 1; a.li = 0; hipLaunchKernelGGL(mk_fwd, dim3(grid), dim3(NTHR), LDS_BYTES, stream, a); }
#else
    a.ph_lo = 0; a.ph_hi = N_PHASES; a.li = 0;
    hipLaunchKernelGGL(mk_fwd, dim3(grid), dim3(NTHR), LDS_BYTES, stream, a);
#endif
    const hipError_t le = hipPeekAtLastError();
    if (le != hipSuccess) fprintf(stderr, "kernel_launch: launch failed: %s\n", hipGetErrorName(le));
}
```

```cpp
#include <hip/hip_runtime.h>
#include <cstdio>
namespace pg8 {
#define PG8_LAS __attribute__((address_space(3)))
typedef unsigned short bf16_t;
typedef short bf16x8 __attribute__((ext_vector_type(8)));
typedef float f32x4 __attribute__((ext_vector_type(4)));
typedef unsigned u32x4 __attribute__((ext_vector_type(4)));
constexpr int BM = 256, BK = 64, HALF = 128, HTB = HALF * BK * 2  , STAGE_BYTES = 8 * HTB, NXCD = 8, WGM = 8;

__host__ __device__ __forceinline__ int lds_byte(int r, int c) { const int st = (r >> 4) * 2 + (c >> 5), rr = r & 15, cc = c & 31, ob = rr * 64 + cc * 2; return st * 1024 + (ob ^ (((ob >> 9) & 1) << 5)); }
__host__ __device__ __forceinline__ void stage_rc(int b, int& R, int& C) { const int st = b / 1024, sb = b % 1024, swz = sb ^ (((sb >> 9) & 1) << 5); R = (st >> 1) * 16 + swz / 64; C = (st & 1) * 32 + (swz % 64) / 2; }
__host__ __device__ __forceinline__ int perm32(int rho) { const int n = rho >> 4, i = rho & 15; return 8 * (i >> 2) + 4 * n + (i & 3); }

struct Unit { int pm, pn, aux0, aux1; };
struct Gemm { const bf16_t* A; const bf16_t* Bt; int M, N, K; };

struct StaticOrder {
    static constexpr bool GATHER = false;
    int nM, nN, nwg, G, c;
    __host__ __device__ void init(int M, int N, int G_, int c_) { nM = M / BM; nN = N / BM; nwg = nM * nN; G = G_; c = c_; }
    __host__ __device__ bool next(int i, Unit& u) const {
        const long L = (long)i * G + c; if (L >= nwg) return false;
        int wgid = (int)L; { const int q = nwg / NXCD, r = nwg % NXCD, xcd = wgid % NXCD, off = wgid / NXCD; wgid = (xcd < r ? xcd * (q + 1) : r * (q + 1) + (xcd - r) * q) + off; }
        const int nig = WGM * nN, gid = wgid / nig, fm = gid * WGM, gsz = (nM - fm) < WGM ? (nM - fm) : WGM;
        u.pm = fm + ((wgid % nig) % gsz); u.pn = (wgid % nig) / gsz; return true;
    }
    __device__ __forceinline__ void a_ready(const Unit&) const {}
    __device__ __forceinline__ void done(const Unit&) const {}
};
__device__ __forceinline__ unsigned cvt_pk_bf16(float lo, float hi) { unsigned r; asm volatile("v_cvt_pk_bf16_f32 %0, %1, %2" : "=v"(r) : "v"(lo), "v"(hi)); return r; }
template <class Epi, class Sched, bool ALIGN_EPI = false, bool SP2 = false, bool FP8 = false>
__device__ __forceinline__ void gemm_phase(PG8_LAS unsigned char* lds, const Gemm g, const Sched& S, const Epi& E) {
    int tid_o = threadIdx.x; asm volatile("" : "+v"(tid_o));
    const int tid = tid_o, wid = __builtin_amdgcn_readfirstlane(tid >> 6), lane = tid & 63, wr = wid >> 2, wc = wid & 3, fr = lane & 15, fq = lane >> 4;
    const int K = g.K, nt = FP8 ? K / (2 * BK) : K / BK;
    const int mx_one = 0x7f7f7f7f;
    unsigned voffA[2], voffB[2]; int RA[2]; unsigned CA[2];
#pragma unroll
    for (int i = 0; i < 2; ++i) { int R, C; stage_rc(tid * 16 + i * 8192, R, C); const int Rb = Epi::PERM ? ((R & ~31) + perm32(R & 31)) : R;
        voffA[i] = FP8 ? (unsigned)(R * K + C * 2) : (unsigned)(R * K + C) * 2u; voffB[i] = FP8 ? (unsigned)(Rb * K + C * 2) : (unsigned)(Rb * K + C) * 2u; RA[i] = R; CA[i] = (unsigned)C * 2u; }
    unsigned vA[2][2], vAn[2][2];
    const size_t kstep = (size_t)(BK * 2);
    const size_t hstep = (size_t)HALF * K * (FP8 ? 1 : 2);
    const size_t tstep = 2 * hstep;
    const unsigned ldsw = (unsigned)wid * 1024u;
    const int aoff = lds_byte(wr * 64 + fr, fq * 8), boff = lds_byte(wc * 32 + fr, fq * 8);
#define PG8_SA(b, h) (((b) * 2 + (h)) * HTB)
#define PG8_SB(b, h) ((4 + (b) * 2 + (h)) * HTB)
#define PG8_STAGE(bufoff, gbase, voff) do { _Pragma("unroll") for (int _i = 0; _i < 2; ++_i) \
        __builtin_amdgcn_global_load_lds((const unsigned*)((const char*)(gbase) + (voff)[_i]), (PG8_LAS unsigned*)(lds + (bufoff) + ldsw + _i * 8192), 16, 0, 0); } while (0)
#define PG8_GVOFF(u, dst) do { if constexpr (Sched::GATHER) { _Pragma("unroll") for (int _h = 0; _h < 2; ++_h) _Pragma("unroll") for (int _i = 0; _i < 2; ++_i) dst[_h][_i] = S.a_rowoff(u, _h * HALF + RA[_i]) + CA[_i]; } } while (0)
#define PG8_STAGE_A(bufoff, gbase, h, nx) do { if constexpr (Sched::GATHER) { unsigned _v[2]; _Pragma("unroll") for (int _i = 0; _i < 2; ++_i) _v[_i] = (nx) ? vAn[h][_i] : vA[h][_i]; PG8_STAGE(bufoff, gbase, _v); } \
        else { PG8_STAGE(bufoff, (gbase) + (h) * hstep, voffA); } } while (0)
#define PG8_LDA(dst, b, h) do { _Pragma("unroll") for (int m = 0; m < 4; ++m) _Pragma("unroll") for (int k = 0; k < 2; ++k) dst[m][k] = *(const PG8_LAS bf16x8*)(lds + PG8_SA(b, h) + aoff + m * 2048 + k * 1024); } while (0)
#define PG8_LDB(dst, b, h) do { _Pragma("unroll") for (int n = 0; n < 2; ++n) _Pragma("unroll") for (int k = 0; k < 2; ++k) dst[n][k] = *(const PG8_LAS bf16x8*)(lds + PG8_SB(b, h) + boff + n * 2048 + k * 1024); } while (0)
#define PG8_MMA(ai, bj, At, Bt) do { __builtin_amdgcn_s_setprio(1); \
        if constexpr (FP8) { typedef int i32x8_ __attribute__((ext_vector_type(8))); typedef int i32x4_ __attribute__((ext_vector_type(4))); \
            _Pragma("unroll") for (int m = 0; m < 4; ++m) _Pragma("unroll") for (int n = 0; n < 2; ++n) { \
                const i32x8_ _av = __builtin_shufflevector(__builtin_bit_cast(i32x4_, At[m][0]), __builtin_bit_cast(i32x4_, At[m][1]), 0, 1, 2, 3, 4, 5, 6, 7); \
                const i32x8_ _bv = __builtin_shufflevector(__builtin_bit_cast(i32x4_, Bt[n][0]), __builtin_bit_cast(i32x4_, Bt[n][1]), 0, 1, 2, 3, 4, 5, 6, 7); \
                asm volatile("v_mfma_scale_f32_16x16x128_f8f6f4 %0, %1, %2, %0, %3, %3 op_sel_hi:[0,0,0]" : "+v"(acc[ai][bj][m][n]) : "v"(_bv), "v"(_av), "v"(mx_one)); } } \
        else { _Pragma("unroll") for (int m = 0; m < 4; ++m) _Pragma("unroll") for (int n = 0; n < 2; ++n) _Pragma("unroll") for (int k = 0; k < 2; ++k) \
            acc[ai][bj][m][n] = __builtin_amdgcn_mfma_f32_16x16x32_bf16(Bt[n][k], At[m][k], acc[ai][bj][m][n], 0, 0, 0); } \
        __builtin_amdgcn_s_setprio(0); } while (0)
#define PG8_WAIT_V(n) asm volatile("s_waitcnt vmcnt(" #n ")" ::: "memory")
#define PG8_WAIT_L(n) asm volatile("s_waitcnt lgkmcnt(" #n ")" ::: "memory")
#define PG8_BAR __builtin_amdgcn_s_barrier()
#define PG8_SCHED __builtin_amdgcn_sched_barrier(0)
    Unit cur, nxt; int ui = 0;
    if (!S.next(0, cur)) return;
    f32x4 acc[2][2][4][2];
#pragma unroll
    for (int a = 0; a < 2; ++a)
#pragma unroll
        for (int b = 0; b < 2; ++b)
#pragma unroll
            for (int m = 0; m < 4; ++m)
#pragma unroll
                for (int n = 0; n < 2; ++n) acc[a][b][m][n] = (f32x4){0.f, 0.f, 0.f, 0.f};
    bf16x8 At[4][2], B0[2][2], B1[2][2];
    const char* cA = (const char*)g.A + (Sched::GATHER ? (size_t)0 : (size_t)cur.pm * tstep); const char* cB = (const char*)g.Bt + (size_t)cur.pn * tstep;
    S.a_ready(cur);
    PG8_GVOFF(cur, vA);
    if constexpr (SP2) {
        PG8_STAGE(PG8_SB(0, 0), cB, voffB); PG8_STAGE(PG8_SB(0, 1), cB + hstep, voffB); PG8_STAGE_A(PG8_SA(0, 0), cA, 0, false); PG8_STAGE_A(PG8_SA(0, 1), cA, 1, false);
        if (wr == 1) PG8_BAR;
        PG8_WAIT_V(2); PG8_BAR;
        PG8_STAGE(PG8_SB(1, 0), cB + kstep, voffB); PG8_STAGE_A(PG8_SA(1, 0), cA + kstep, 0, false); PG8_STAGE(PG8_SB(1, 1), cB + hstep + kstep, voffB);
        PG8_WAIT_V(6); PG8_BAR;
    } else {
        PG8_STAGE(PG8_SB(0, 0), cB, voffB); PG8_STAGE_A(PG8_SA(0, 0), cA, 0, false); PG8_STAGE(PG8_SB(0, 1), cB + hstep, voffB); PG8_STAGE_A(PG8_SA(0, 1), cA, 1, false);
        if (wr == 1) PG8_BAR;
        PG8_WAIT_V(4); PG8_BAR;
        PG8_STAGE(PG8_SB(1, 0), cB + kstep, voffB); PG8_STAGE_A(PG8_SA(1, 0), cA + kstep, 0, false); PG8_STAGE(PG8_SB(1, 1), cB + hstep + kstep, voffB);
        PG8_WAIT_V(6); PG8_BAR;
    }
    for (;;) {
        const bool has_next = S.next(ui + 1, nxt);
        const char* nA = (has_next && !Sched::GATHER) ? (const char*)g.A + (size_t)nxt.pm * tstep : cA; const char* nB = has_next ? (const char*)g.Bt + (size_t)nxt.pn * tstep : cB;
        if constexpr (Sched::GATHER) { if (has_next) { PG8_GVOFF(nxt, vAn); } else { _Pragma("unroll") for (int _h = 0; _h < 2; ++_h) _Pragma("unroll") for (int _i = 0; _i < 2; ++_i) vAn[_h][_i] = vA[_h][_i]; } }
#pragma unroll 1
        for (int t = 0; t < nt; t += 2) {
            const bool last = (t == nt - 2);
            const char* a1 = cA + (size_t)(t + 1) * kstep;
            const char* a2 = last ? nA : cA + (size_t)(t + 2) * kstep; const char* b2 = last ? nB : cB + (size_t)(t + 2) * kstep;
            const char* a3 = a2 + kstep; const char* b3 = b2 + kstep;
            if (last && has_next) S.a_ready(nxt);
            if constexpr (SP2) {
            PG8_LDB(B0, 0, 0); PG8_LDB(B1, 0, 1); PG8_SCHED; PG8_LDA(At, 0, 0); PG8_STAGE_A(PG8_SA(1, 1), a1, 1, false);
            PG8_WAIT_V(8); PG8_WAIT_L(0); PG8_BAR; PG8_MMA(0, 0, At, B0); PG8_MMA(0, 1, At, B1); PG8_BAR; PG8_SCHED;
            PG8_LDA(At, 0, 1); PG8_STAGE(PG8_SB(0, 0), b2, voffB); PG8_STAGE(PG8_SB(0, 1), b2 + hstep, voffB); PG8_STAGE_A(PG8_SA(0, 0), a2, 0, last);
            PG8_WAIT_V(8); PG8_WAIT_L(0); PG8_BAR; PG8_MMA(1, 0, At, B0); PG8_MMA(1, 1, At, B1); PG8_BAR; PG8_SCHED;
            PG8_LDB(B0, 1, 0); PG8_LDB(B1, 1, 1); PG8_SCHED; PG8_LDA(At, 1, 0); PG8_STAGE_A(PG8_SA(0, 1), a2, 1, last);
            PG8_WAIT_V(8); PG8_WAIT_L(0); PG8_BAR; PG8_MMA(0, 0, At, B0); PG8_MMA(0, 1, At, B1); PG8_BAR; PG8_SCHED;
            PG8_LDA(At, 1, 1); PG8_STAGE(PG8_SB(1, 0), b3, voffB); PG8_STAGE(PG8_SB(1, 1), b3 + hstep, voffB); PG8_STAGE_A(PG8_SA(1, 0), a3, 0, last);
            PG8_WAIT_V(8); PG8_WAIT_L(0); PG8_BAR; PG8_MMA(1, 0, At, B0); PG8_MMA(1, 1, At, B1); PG8_BAR; PG8_SCHED;
            } else {
            PG8_LDB(B0, 0, 0); PG8_SCHED; PG8_LDA(At, 0, 0); PG8_STAGE_A(PG8_SA(1, 1), a1, 1, false);
            PG8_WAIT_L(8); PG8_BAR; PG8_WAIT_L(0); PG8_MMA(0, 0, At, B0); PG8_BAR; PG8_SCHED;
            PG8_LDB(B1, 0, 1); PG8_STAGE(PG8_SB(0, 0), b2, voffB);
            PG8_BAR; PG8_WAIT_L(0); PG8_MMA(0, 1, At, B1); PG8_BAR;
            PG8_LDA(At, 0, 1); PG8_STAGE_A(PG8_SA(0, 0), a2, 0, last);
            PG8_BAR; PG8_WAIT_L(0); PG8_MMA(1, 0, At, B0); PG8_BAR; PG8_SCHED;
            PG8_STAGE(PG8_SB(0, 1), b2 + hstep, voffB);
            PG8_WAIT_V(6); PG8_BAR; PG8_MMA(1, 1, At, B1); PG8_BAR;
            PG8_LDB(B0, 1, 0); PG8_SCHED; PG8_LDA(At, 1, 0); PG8_STAGE_A(PG8_SA(0, 1), a2, 1, last);
            PG8_WAIT_L(8); PG8_BAR; PG8_WAIT_L(0); PG8_MMA(0, 0, At, B0); PG8_BAR; PG8_SCHED;
            PG8_LDB(B1, 1, 1); PG8_STAGE(PG8_SB(1, 0), b3, voffB);
            PG8_BAR; PG8_WAIT_L(0); PG8_MMA(0, 1, At, B1); PG8_BAR;
            PG8_LDA(At, 1, 1); PG8_STAGE_A(PG8_SA(1, 0), a3, 0, last);
            PG8_BAR; PG8_WAIT_L(0); PG8_MMA(1, 0, At, B0); PG8_BAR; PG8_SCHED;
            PG8_STAGE(PG8_SB(1, 1), b3 + hstep, voffB);
            PG8_WAIT_V(6); PG8_BAR; PG8_MMA(1, 1, At, B1); PG8_BAR;
            }
        }
        if constexpr (ALIGN_EPI) { if (wr == 0) PG8_BAR; }
        if constexpr (!Epi::AFTER_DRAIN) { E(acc, cur, wr, wc, fr, fq); S.done(cur); }
        if (!has_next) break;
#pragma unroll
        for (int a = 0; a < 2; ++a)
#pragma unroll
            for (int b = 0; b < 2; ++b)
#pragma unroll
                for (int m = 0; m < 4; ++m)
#pragma unroll
                    for (int n = 0; n < 2; ++n) acc[a][b][m][n] = (f32x4){0.f, 0.f, 0.f, 0.f};
        cur = nxt; cA = nA; cB = nB; ++ui;
        if constexpr (Sched::GATHER) { _Pragma("unroll") for (int _h = 0; _h < 2; ++_h) _Pragma("unroll") for (int _i = 0; _i < 2; ++_i) vA[_h][_i] = vAn[_h][_i]; }
        if constexpr (ALIGN_EPI) { if (wr == 1) PG8_BAR; }
    }
    PG8_WAIT_V(0);
    if constexpr (!ALIGN_EPI) { if (wr == 0) PG8_BAR; }
    PG8_BAR;
    if constexpr (Epi::AFTER_DRAIN) { E.fused(acc, cur, wr, wc, fr, fq, lds, wid, lane); S.done(cur); }
#undef PG8_SA
#undef PG8_SB
#undef PG8_STAGE
#undef PG8_GVOFF
#undef PG8_STAGE_A
#undef PG8_LDA
#undef PG8_LDB
#undef PG8_MMA
#undef PG8_WAIT_V
#undef PG8_WAIT_L
#undef PG8_BAR
#undef PG8_SCHED
}
}

#define XB_TMO      128
#define XB_XCNT(j)  (256  + 64 * (j))
#define XB_XSUB(j)  (1280 + 64 * (j))
#define XB_XGEN(j)  (2304 + 64 * (j))
#define XB_TOP      3328
#define XB_TOPGEN   3392
#define XCD_BAR_WORDS 3456
#define XB_SPIN_CAP (1u << 18)
#define LAS __attribute__((address_space(3)))

__device__ __forceinline__ unsigned xb_ld(unsigned* p)              { return __hip_atomic_load(p, __ATOMIC_RELAXED, __HIP_MEMORY_SCOPE_AGENT); }
__device__ __forceinline__ unsigned xb_add(unsigned* p, unsigned v) { return __hip_atomic_fetch_add(p, v, __ATOMIC_RELAXED, __HIP_MEMORY_SCOPE_AGENT); }
__device__ __forceinline__ unsigned xb_xcc_id() { return (unsigned)__builtin_amdgcn_s_getreg((3 << 11) | 20) & 0xFu; }
#define XB_SPIN(cond, bar) do { unsigned _sp = 0; while (cond) { __builtin_amdgcn_s_sleep(1); \
    if ((++_sp & 255u) == 0u) { if (xb_ld(&(bar)[XB_TMO])) break; if (_sp > XB_SPIN_CAP) { atomicAdd(&(bar)[XB_TMO], 1u); break; } } } } while (0)

struct XcdBarrier {
    unsigned* bar; unsigned x;
    volatile LAS unsigned* st;
};

__device__ __forceinline__ XcdBarrier xcd_barrier_post(unsigned* bar, volatile LAS unsigned* st) {
    XcdBarrier b; b.bar = bar; b.x = xb_xcc_id(); b.st = st;
    if (threadIdx.x == 0) (void)xb_add(&bar[XB_XCNT(b.x)], 1u);
    return b;
}
__device__ __forceinline__ void xcd_barrier_complete(unsigned* bar, unsigned x, unsigned& nloc, unsigned& nx) {
    const unsigned G = gridDim.x * gridDim.y * gridDim.z;
    unsigned sum, cnt, mine, sp = 0u;
    for (;;) {
        sum = 0u; cnt = 0u; mine = 0u;
#pragma unroll
        for (unsigned j = 0; j < 16; ++j) { const unsigned c = xb_ld(&bar[XB_XCNT(j)]); sum += c; cnt += (c > 0u) ? 1u : 0u; mine = (j == x) ? c : mine; }
        if (sum == G) break;
        __builtin_amdgcn_s_sleep(1);
        if ((++sp & 255u) == 0u) { if (xb_ld(&bar[XB_TMO])) break; if (sp > XB_SPIN_CAP) { atomicAdd(&bar[XB_TMO], 1u); break; } }
    }
    nloc = mine > 0u ? mine : 1u; nx = cnt > 0u ? cnt : 1u;
}

__device__ __forceinline__ void xcd_barrier(const XcdBarrier& b) {
    asm volatile("s_waitcnt vmcnt(0)" ::: "memory");
    __syncthreads();
    if (threadIdx.x == 0) {
        unsigned* bar = b.bar;
        __builtin_amdgcn_s_waitcnt(0);
        unsigned nloc = b.st[0], nx = b.st[1];
        if (nloc == 0u) { xcd_barrier_complete(bar, b.x, nloc, nx); b.st[0] = nloc; b.st[1] = nx; }
        const unsigned old = xb_add(&bar[XB_XSUB(b.x)], 1u);
        const unsigned gen = old / nloc;
        if (old + 1u == (gen + 1u) * nloc) {
            __builtin_amdgcn_fence(__ATOMIC_RELEASE, "agent");
            asm volatile("s_waitcnt vmcnt(0)" ::: "memory");
            const unsigned og = xb_add(&bar[XB_TOP], 1u);
            const unsigned tg = og / nx;
            if (og + 1u == (tg + 1u) * nx) xb_add(&bar[XB_TOPGEN], 1u);
            else XB_SPIN(xb_ld(&bar[XB_TOPGEN]) == tg, bar);
            __builtin_amdgcn_fence(__ATOMIC_ACQUIRE, "agent");
            xb_add(&bar[XB_XGEN(b.x)], 1u);
            asm volatile("s_waitcnt vmcnt(0)" ::: "memory");
        } else {
            XB_SPIN(xb_ld(&bar[XB_XGEN(b.x)]) == gen, bar);
            __builtin_amdgcn_fence(__ATOMIC_ACQUIRE, "agent");
            asm volatile("s_waitcnt vmcnt(0)" ::: "memory");
        }
    }
    __syncthreads();
}


#ifndef PHMASK
#define PHMASK 0x1ffff
#endif
#define EN(j) (((PHMASK) >> (j)) & 1)
#ifndef GEMM_ALIGN
#define GEMM_ALIGN true
#endif
#ifndef GEMM_SP2
#define GEMM_SP2 true
#endif
#ifndef STORE_T
#define STORE_T 1
#endif
#ifndef STAG_D
#define STAG_D 0
#endif
#ifndef STAG_GU
#define STAG_GU 0
#endif
#ifndef L3MASK
#define L3MASK 7
#endif
#ifndef MK_SPLIT
#define MK_SPLIT 0
#endif

#define GAS __attribute__((address_space(1)))
typedef unsigned short bf16;
typedef unsigned v4u __attribute__((ext_vector_type(4)));
typedef unsigned v2u __attribute__((ext_vector_type(2)));
typedef float f32x4 __attribute__((ext_vector_type(4)));
typedef short bf16x8 __attribute__((ext_vector_type(8)));
using pg8::Unit;

constexpr int T = 16384, D = 1024, SEQ = 2048, NL = 4, DIN = 2320, NE = 128;
constexpr float EPS = 1e-6f;
constexpr int NWAVES = 8, NTHR = 512;
constexpr size_t MiB = 1u << 20;
constexpr size_t WS_CTL = 0, CTL_BYTES = 1 * MiB;
constexpr size_t WS_WIN = 1 * MiB, WS_WPQ = 17 * MiB, WS_WOUT = 21 * MiB, WS_RS = 29 * MiB, WS_PLEIN = 35 * MiB, WS_PLEG = 37 * MiB, WS_GWS = 45 * MiB, WS_CSW = 46 * MiB, WS_DFT = 47 * MiB;
constexpr size_t RS_L = 768 * 1024 * 2;
constexpr size_t WS_WGU = 64 * MiB, WGU_L = 128 * MiB;
constexpr size_t WS_WD = 576 * MiB, WD_L = 129 * 1024 * 256 * 2;
constexpr size_t WS_H = 838 * MiB, WS_XM = 902 * MiB, WS_Y = 934 * MiB, WS_HB = 1222 * MiB, WS_Z = 1254 * MiB, WS_GATES = 1318 * MiB, WS_PQT = 1319 * MiB, WS_MIX = 1335 * MiB;
constexpr size_t WS_CLOC = 1367 * MiB, WS_CPREV = 1399 * MiB, WS_SMALL = 1415 * MiB, WS_LOGIT = 1416 * MiB, WS_TOPK = 1424 * MiB, WS_ACT = 1426 * MiB, WS_E = 1498 * MiB, WS_GE = 1626 * MiB, WS_PB = 1658 * MiB, WS_LIST = 1690 * MiB;
constexpr size_t WS_XM8 = 1698 * MiB;
constexpr size_t WS_END = 1714 * MiB;
constexpr size_t WS_FLAGS = 63 * MiB, FLAGS_BYTES = 1 * MiB;
constexpr int NGU = 128;
constexpr float SX8 = 8.f, SW8 = 64.f, SA8 = 8.f;
constexpr size_t ACT8_OFF = 8 * MiB, WD8_OFF = 1 * MiB;
constexpr size_t WS_PQF = WS_DFT + 8 * MiB;
constexpr int LCAP = 16384;
constexpr int CW_BAR = 4096;
constexpr int CW_CNT = 240000;
static_assert((CW_CNT + 4 * 256) * 4 <= (int)CTL_BYTES && CW_BAR + 64 * XCD_BAR_WORDS <= CW_CNT, "ctl map");
constexpr int LDS_RING = 131072, LDS_TBL = LDS_RING, LDS_MISC = LDS_RING + 2048, LDS_DESC = LDS_RING + 1104, LDS_ROWTAB = LDS_RING + 4096, LDS_BYTES = 155648;

__device__ __forceinline__ unsigned f2bf(float f) { unsigned u = __float_as_uint(f); return (u + 0x7fffu + ((u >> 16) & 1u)) >> 16; }
__device__ __forceinline__ unsigned pk2(float lo, float hi) { unsigned r; asm("v_cvt_pk_bf16_f32 %0, %1, %2" : "=v"(r) : "v"(lo), "v"(hi)); return r; }
__device__ __forceinline__ float bf2f(unsigned b) { return __uint_as_float(b << 16); }
__device__ __forceinline__ float bflo(unsigned w) { return __uint_as_float(w << 16); }
__device__ __forceinline__ float bfhi(unsigned w) { return __uint_as_float(w & 0xffff0000u); }
__device__ __forceinline__ float sigmoidf_(float x) { return __builtin_amdgcn_rcpf(1.f + __expf(-x)); }
__device__ __forceinline__ float siluf_(float x) { return x * __builtin_amdgcn_rcpf(1.f + __expf(-x)); }
__device__ __forceinline__ float geluf_(float x) { const float t = 1.5957691216f * (x + 0.044715f * x * x * x); return x * __builtin_amdgcn_rcpf(1.f + __expf(-t)); }
__device__ __forceinline__ float logsigf_(float x) { return fminf(x, 0.f) - __logf(1.f + __expf(-fabsf(x))); }
__device__ __forceinline__ float wave_sum(float v) {
#pragma unroll
    for (int o = 1; o < 64; o <<= 1) v += __shfl_xor(v, o);
    return v;
}
__device__ __forceinline__ int otid() { int t = threadIdx.x; asm volatile("" : "+v"(t)); return t; }
#define LDS_FENCE() asm volatile("s_waitcnt lgkmcnt(0)" ::: "memory")
#define MFMA16(a, b, c) __builtin_amdgcn_mfma_f32_16x16x32_bf16((a), (b), (c), 0, 0, 0)


__device__ __forceinline__ v4u lane_xpose(v4u w, int lane) {
    const int src = (((lane & 3) << 4) | (lane >> 2)) << 2; v4u o;
    o.x = (unsigned)__builtin_amdgcn_ds_bpermute(src, (int)w.x); o.y = (unsigned)__builtin_amdgcn_ds_bpermute(src, (int)w.y);
    o.z = (unsigned)__builtin_amdgcn_ds_bpermute(src, (int)w.z); o.w = (unsigned)__builtin_amdgcn_ds_bpermute(src, (int)w.w); return o;
}


__device__ __forceinline__ void stagger(int q, unsigned ticks) {
    if (ticks == 0u || q == 0) return;
    const unsigned long long t0 = __builtin_amdgcn_s_memrealtime(); const unsigned long long d = (unsigned long long)q * ticks;
    while (__builtin_amdgcn_s_memrealtime() - t0 < d) __builtin_amdgcn_s_sleep(8);
}

struct RangeOrder {
    static constexpr bool GATHER = false;
    int start, count, nN;
    __device__ __forceinline__ bool next(int i, Unit& u) const { if (i >= count) return false; const int j = start + i; u.pm = j / nN; u.pn = j % nN; return true; }
    __device__ __forceinline__ void a_ready(const Unit&) const {}
    __device__ __forceinline__ void done(const Unit&) const {}
};
struct StackOrder {
    static constexpr bool GATHER = false;
    int nl, nM, nN, G, c;
    __device__ __forceinline__ bool next(int i, Unit& u) const { const int L = i * G + c; if (L >= nl * nM * nN) return false; const int l = L / (nM * nN), r = L % (nM * nN); u.pm = l * nM + r / nN; u.pn = l * nN + r % nN; return true; }
    __device__ __forceinline__ void a_ready(const Unit&) const {}
    __device__ __forceinline__ void done(const Unit&) const {}
};
template <int MODE> struct MoeOrder {
    static constexpr bool GATHER = true;
    const LAS int* desc; const LAS int* rowtab; int nunits, shift; unsigned rowbytes; unsigned* flags;
    __device__ __forceinline__ bool next(int i, Unit& u) const {
        if (i >= nunits) return false;
        u.pn = __builtin_amdgcn_readfirstlane(desc[3 * i]); u.aux0 = i * 256; u.aux1 = __builtin_amdgcn_readfirstlane(desc[3 * i + 1]); u.pm = __builtin_amdgcn_readfirstlane(desc[3 * i + 2]); return true; }
    __device__ __forceinline__ unsigned a_rowoff(const Unit& u, int r) const { return (unsigned)(rowtab[u.aux0 + r] >> shift) * rowbytes; }
    __device__ __forceinline__ void a_ready(const Unit& u) const {
        if (MODE == 2) {
            if (threadIdx.x < 64) {
                const unsigned long long t0 = __builtin_amdgcn_s_memrealtime();
                while ((unsigned)__builtin_amdgcn_readfirstlane(__hip_atomic_load(flags + 64 * u.pm, __ATOMIC_RELAXED, __HIP_MEMORY_SCOPE_AGENT)) < 16u) {
                    if (__builtin_amdgcn_s_memrealtime() - t0 > 2000000ull) break;
                    __builtin_amdgcn_s_sleep(2); }
                __builtin_amdgcn_fence(__ATOMIC_ACQUIRE, "agent");
                asm volatile("s_waitcnt vmcnt(0)" ::: "memory");
            }
            asm volatile("" ::: "memory"); __builtin_amdgcn_s_barrier(); asm volatile("" ::: "memory");
        }
    }
    __device__ __forceinline__ void done(const Unit& u) const {
        if (MODE == 1) {
            asm volatile("s_waitcnt vmcnt(0)" ::: "memory");
            if ((threadIdx.x & 63) == 0) __hip_atomic_fetch_add(flags + 64 * u.pm, 1u, __ATOMIC_RELAXED, __HIP_MEMORY_SCOPE_AGENT);
        }
    }
};
struct EpiStoreBf16 {
    static constexpr bool PERM = true, AFTER_DRAIN = false;
    bf16* O; int ldc; int cmask;
    __device__ __forceinline__ void operator()(const f32x4 (&acc)[2][2][4][2], const Unit& u, int wr, int wc, int fr, int fq) const {
        const int lane = fq * 16 + fr, frs = STORE_T ? (lane >> 2) : fr, fqs = STORE_T ? (lane & 3) : fq;
        const int row0 = u.pm * 256 + wr * 64 + frs, col0 = (u.pn & cmask) * 256 + wc * 32 + 8 * fqs;
#pragma unroll
        for (int ai = 0; ai < 2; ++ai)
#pragma unroll
            for (int m = 0; m < 4; ++m) { bf16* rowp = O + (size_t)(row0 + ai * 128 + m * 16) * ldc + col0;
#pragma unroll
                for (int bj = 0; bj < 2; ++bj) { const f32x4 v0 = acc[ai][bj][m][0], v1 = acc[ai][bj][m][1];
                    v4u w; w.x = pk2(v0[0], v0[1]); w.y = pk2(v0[2], v0[3]); w.z = pk2(v1[0], v1[1]); w.w = pk2(v1[2], v1[3]);
                    if (STORE_T) w = lane_xpose(w, lane);
                    *(v4u*)(rowp + bj * 128) = w; } }
    }
};
struct EpiPQ {
    static constexpr bool PERM = true, AFTER_DRAIN = false;
    bf16* O;
    __device__ __forceinline__ void operator()(const f32x4 (&acc)[2][2][4][2], const Unit& u, int wr, int wc, int fr, int fq) const {
        const int row0 = u.pm * 256 + wr * 64 + fr, t0 = u.pn * 256 + wc * 32 + 8 * fq;
#pragma unroll
        for (int ai = 0; ai < 2; ++ai)
#pragma unroll
            for (int m = 0; m < 4; ++m) { const int c = row0 + ai * 128 + m * 16;
#pragma unroll
                for (int bj = 0; bj < 2; ++bj) { const int t = t0 + bj * 128, b = t >> 11, s = t & 2047;
                    const f32x4 v0 = acc[ai][bj][m][0], v1 = acc[ai][bj][m][1];
                    v4u w; w.x = pk2(v0[0], v0[1]); w.y = pk2(v0[2], v0[3]); w.z = pk2(v1[0], v1[1]); w.w = pk2(v1[2], v1[3]);
                    *(v4u*)(O + ((size_t)(b * 256 + (c & 255)) * 4096 + (c >> 8) * 2048 + s)) = w; } }
    }
};
struct EpiFourier {
    static constexpr bool PERM = true, AFTER_DRAIN = false;
    bf16* O;
    __device__ __forceinline__ void operator()(const f32x4 (&acc)[2][2][4][2], const Unit& u, int wr, int wc, int fr, int fq) const {
        const int row0 = u.pm * 256 + wr * 64 + fr, c0 = wc * 32 + 8 * fq, b = u.pn;
#pragma unroll
        for (int ai = 0; ai < 2; ++ai)
#pragma unroll
            for (int m = 0; m < 4; ++m) { bf16* rowp = O + (size_t)(b * 2048 + row0 + ai * 128 + m * 16) * 1024 + c0;
#pragma unroll
                for (int bj = 0; bj < 2; ++bj) { const f32x4 v0 = acc[ai][bj][m][0], v1 = acc[ai][bj][m][1];
                    v4u w; w.x = pk2(v0[0], v0[1]); w.y = pk2(v0[2], v0[3]); w.z = pk2(v1[0], v1[1]); w.w = pk2(v1[2], v1[3]);
                    *(v4u*)(rowp + bj * 128) = w; } }
    }
};
struct EpiResid {
    static constexpr bool PERM = false, AFTER_DRAIN = false;
    float* H;
    __device__ __forceinline__ void operator()(const f32x4 (&acc)[2][2][4][2], const Unit& u, int wr, int wc, int fr, int fq) const {
        const int row0 = u.pm * 256 + wr * 64 + fr, col0 = u.pn * 256 + wc * 32 + 4 * fq;
#pragma unroll
        for (int ai = 0; ai < 2; ++ai)
#pragma unroll
            for (int m = 0; m < 4; ++m) { float* rowp = H + (size_t)(row0 + ai * 128 + m * 16) * D + col0;
#pragma unroll
                for (int bj = 0; bj < 2; ++bj)
#pragma unroll
                    for (int n = 0; n < 2; ++n) { f32x4* p = (f32x4*)(rowp + bj * 128 + n * 16); *p = *p + acc[ai][bj][m][n]; } }
    }
};
struct EpiRouterShared {
    static constexpr bool PERM = true, AFTER_DRAIN = false;
    float* Lg; bf16* Act;
    __device__ __forceinline__ void operator()(const f32x4 (&acc)[2][2][4][2], const Unit& u, int wr, int wc, int fr, int fq) const {
        const int row0 = u.pm * 256 + wr * 64 + fr;
        if (u.pn == 0) {
#pragma unroll
            for (int ai = 0; ai < 2; ++ai)
#pragma unroll
                for (int m = 0; m < 4; ++m) { float* rowp = Lg + (size_t)(row0 + ai * 128 + m * 16) * 128 + wc * 32 + 8 * fq;
                    *(f32x4*)rowp = acc[ai][0][m][0]; *(f32x4*)(rowp + 4) = acc[ai][0][m][1]; }
        } else {
            const int col0 = (u.pn - 1) * 128 + wc * 32 + 8 * fq;
#pragma unroll
            for (int ai = 0; ai < 2; ++ai)
#pragma unroll
                for (int m = 0; m < 4; ++m) { float o[8];
#pragma unroll
                    for (int n = 0; n < 2; ++n)
#pragma unroll
                        for (int i = 0; i < 4; ++i) o[n * 4 + i] = siluf_(acc[ai][0][m][n][i]) * acc[ai][1][m][n][i];
                    v4u w; w.x = pk2(o[0], o[1]); w.y = pk2(o[2], o[3]); w.z = pk2(o[4], o[5]); w.w = pk2(o[6], o[7]);
                    *(v4u*)(Act + (size_t)(row0 + ai * 128 + m * 16) * 256 + col0) = w; }
        }
    }
};
struct EpiSwigluScatter {
    static constexpr bool PERM = true, AFTER_DRAIN = false;
    unsigned char* Act; const LAS int* list; float sc;
    __device__ __forceinline__ void operator()(const f32x4 (&acc)[2][2][4][2], const Unit& u, int wr, int wc, int fr, int fq) const {
        const int r0 = wr * 64 + fr, col0 = (u.pn & 1) * 128 + wc * 32 + 8 * fq;
#pragma unroll
        for (int ai = 0; ai < 2; ++ai)
#pragma unroll
            for (int m = 0; m < 4; ++m) { const int r = r0 + ai * 128 + m * 16;
                if (r < u.aux1) { const int pid = list[u.aux0 + r]; float o[8];
#pragma unroll
                    for (int n = 0; n < 2; ++n)
#pragma unroll
                        for (int i = 0; i < 4; ++i) o[n * 4 + i] = siluf_(acc[ai][0][m][n][i] * sc) * (acc[ai][1][m][n][i] * sc);
                    v2u w; w.x = (unsigned)__builtin_amdgcn_cvt_pk_fp8_f32(o[2] * SA8, o[3] * SA8, __builtin_amdgcn_cvt_pk_fp8_f32(o[0] * SA8, o[1] * SA8, 0, false), true);
                    w.y = (unsigned)__builtin_amdgcn_cvt_pk_fp8_f32(o[6] * SA8, o[7] * SA8, __builtin_amdgcn_cvt_pk_fp8_f32(o[4] * SA8, o[5] * SA8, 0, false), true);
                    *(v2u*)(Act + (size_t)pid * 256 + col0) = w; } }
    }
};
struct EpiYScatter {
    static constexpr bool PERM = true, AFTER_DRAIN = false;
    unsigned char* Y; const LAS int* list; float sc;
    __device__ __forceinline__ void operator()(const f32x4 (&acc)[2][2][4][2], const Unit& u, int wr, int wc, int fr, int fq) const {
        const int lane = fq * 16 + fr, frs = lane >> 2, fqs = lane & 3;
        const int r0 = wr * 64 + frs, col0 = (u.pn & 3) * 256 + wc * 64 + 16 * fqs;
#pragma unroll
        for (int ai = 0; ai < 2; ++ai)
#pragma unroll
            for (int m = 0; m < 4; ++m) { const int r = r0 + ai * 128 + m * 16; const bool ok = r < u.aux1; const int pid = ok ? list[u.aux0 + r] : 0;
                v4u w;
                { const f32x4 a0 = acc[ai][0][m][0] * sc, a1 = acc[ai][0][m][1] * sc, a2 = acc[ai][1][m][0] * sc, a3 = acc[ai][1][m][1] * sc;
                  w.x = (unsigned)__builtin_amdgcn_cvt_pk_fp8_f32(a0[2], a0[3], __builtin_amdgcn_cvt_pk_fp8_f32(a0[0], a0[1], 0, false), true);
                  w.y = (unsigned)__builtin_amdgcn_cvt_pk_fp8_f32(a1[2], a1[3], __builtin_amdgcn_cvt_pk_fp8_f32(a1[0], a1[1], 0, false), true);
                  w.z = (unsigned)__builtin_amdgcn_cvt_pk_fp8_f32(a2[2], a2[3], __builtin_amdgcn_cvt_pk_fp8_f32(a2[0], a2[1], 0, false), true);
                  w.w = (unsigned)__builtin_amdgcn_cvt_pk_fp8_f32(a3[2], a3[3], __builtin_amdgcn_cvt_pk_fp8_f32(a3[0], a3[1], 0, false), true); }
                w = lane_xpose(w, lane);
                if (ok) *(v4u*)(Y + (size_t)pid * 1024 + col0) = w; }
    }
};
struct EpiPleGate {
    static constexpr bool PERM = true, AFTER_DRAIN = false;
    bf16* GE; const bf16* E;
    __device__ __forceinline__ void operator()(const f32x4 (&acc)[2][2][4][2], const Unit& u, int wr, int wc, int fr, int fq) const {
        const int row0 = u.pm * 256 + wr * 64 + fr, col0 = u.pn * 256 + wc * 32 + 8 * fq;
#pragma unroll
        for (int ai = 0; ai < 2; ++ai)
#pragma unroll
            for (int m = 0; m < 4; ++m) { const size_t off = (size_t)(row0 + ai * 128 + m * 16) * D + col0;
#pragma unroll
                for (int bj = 0; bj < 2; ++bj) { const v4u e = __builtin_nontemporal_load((const v4u*)(E + off + bj * 128)); const f32x4 v0 = acc[ai][bj][m][0], v1 = acc[ai][bj][m][1];
                    v4u w; w.x = pk2(sigmoidf_(v0[0]) * bflo(e.x), sigmoidf_(v0[1]) * bfhi(e.x)); w.y = pk2(sigmoidf_(v0[2]) * bflo(e.y), sigmoidf_(v0[3]) * bfhi(e.y));
                    w.z = pk2(sigmoidf_(v1[0]) * bflo(e.z), sigmoidf_(v1[1]) * bfhi(e.z)); w.w = pk2(sigmoidf_(v1[2]) * bflo(e.w), sigmoidf_(v1[3]) * bfhi(e.w));
                    *(v4u*)(GE + off + bj * 128) = w; } }
    }
};

__device__ __forceinline__ void transpose_item(const float* W, int ldw, int k0, int n0, bf16* dst, int Kd, LAS float* scr, int lane, int perm16 = 0, int fp8 = 0) {
#pragma unroll 8
    for (int i = 0; i < 32; ++i) { const int kk = 2 * i + (lane >> 5); scr[kk * 33 + (lane & 31)] = __builtin_nontemporal_load(W + (size_t)(k0 + kk) * ldw + n0 + (lane & 31)); }
    LDS_FENCE();
    const int c = lane & 7;
#pragma unroll
    for (int j = 0; j < 4; ++j) { const int n = (lane >> 3) + 8 * j; const LAS float* s = scr + (8 * c) * 33 + n;
        v4u o; o.x = pk2(s[0 * 33], s[1 * 33]); o.y = pk2(s[2 * 33], s[3 * 33]); o.z = pk2(s[4 * 33], s[5 * 33]); o.w = pk2(s[6 * 33], s[7 * 33]);
        int nr = n;
        if (perm16) { const int cc = (n0 + n) & 255;
            nr = (((cc >> 3) & 1) << 7) + ((cc >> 6) << 5) + (((cc >> 4) & 3) << 3) + (cc & 7) - (n0 & 255); }
        if (fp8) {
            v2u o8; o8.x = (unsigned)__builtin_amdgcn_cvt_pk_fp8_f32(s[2 * 33] * SW8, s[3 * 33] * SW8, __builtin_amdgcn_cvt_pk_fp8_f32(s[0 * 33] * SW8, s[1 * 33] * SW8, 0, false), true);
            o8.y = (unsigned)__builtin_amdgcn_cvt_pk_fp8_f32(s[6 * 33] * SW8, s[7 * 33] * SW8, __builtin_amdgcn_cvt_pk_fp8_f32(s[4 * 33] * SW8, s[5 * 33] * SW8, 0, false), true);
            *(v2u*)((unsigned char*)dst + (ptrdiff_t)nr * Kd + 8 * c) = o8;
        } else *(v4u*)(dst + (ptrdiff_t)nr * Kd + 8 * c) = o; }
    LDS_FENCE();
}

typedef short s16x4_t __attribute__((ext_vector_type(4)));
__device__ __forceinline__ unsigned fp8x4_of_bf16x4(s16x4_t a) {
    const float f0 = __uint_as_float((unsigned)(unsigned short)a[0] << 16), f1 = __uint_as_float((unsigned)(unsigned short)a[1] << 16), f2 = __uint_as_float((unsigned)(unsigned short)a[2] << 16), f3 = __uint_as_float((unsigned)(unsigned short)a[3] << 16);
    return (unsigned)__builtin_amdgcn_cvt_pk_fp8_f32(f2, f3, __builtin_amdgcn_cvt_pk_fp8_f32(f0, f1, 0, false), true);
}
template <bool PERM>
__device__ __forceinline__ void transpose_item8(const float* W, int ldw, int k0, int n0, unsigned char* dmat, int rowbase, int Kd, LAS unsigned char* img, int lane) {
    f32x4 r[32];
    const float* src = W + (size_t)(k0 + (lane >> 4)) * ldw + n0 + 4 * (lane & 15);
#pragma unroll
    for (int i = 0; i < 32; ++i) r[i] = __builtin_nontemporal_load((const f32x4*)(src + (size_t)(4 * i) * ldw));
    LAS unsigned char* wp = img + (lane >> 4) * 144 + 8 * (lane & 15);
#pragma unroll
    for (int i = 0; i < 32; ++i) { v2u w; w.x = pk2(r[i][0] * SW8, r[i][1] * SW8); w.y = pk2(r[i][2] * SW8, r[i][3] * SW8); *(LAS v2u*)(wp + 4 * i * 144) = w; }
    LDS_FENCE();
    const int g = lane >> 4, i16 = lane & 15;
    const LAS unsigned char* rp = img + (16 * g + (i16 >> 2)) * 144 + 8 * (i16 & 3);
#pragma unroll
    for (int nn = 0; nn < 4; ++nn) {
        const int n = n0 + 16 * nn + i16; int row;
        if (PERM) { const int cc = n & 255; row = (n & ~255) + (((cc >> 3) & 1) << 7) + ((cc >> 6) << 5) + (((cc >> 4) & 3) << 3) + (cc & 7); }
        else row = 256 * (n >> 7) + (n & 127);
        unsigned char* d = dmat + (size_t)(rowbase + row) * Kd + k0 + 16 * g;
#pragma unroll
        for (int kk = 0; kk < 2; ++kk) { v4u o;
            o.x = fp8x4_of_bf16x4(__builtin_amdgcn_ds_read_tr16_b64_v4i16((LAS s16x4_t*)(rp + (64 * kk + 0) * 144 + 32 * nn)));
            o.y = fp8x4_of_bf16x4(__builtin_amdgcn_ds_read_tr16_b64_v4i16((LAS s16x4_t*)(rp + (64 * kk + 4) * 144 + 32 * nn)));
            o.z = fp8x4_of_bf16x4(__builtin_amdgcn_ds_read_tr16_b64_v4i16((LAS s16x4_t*)(rp + (64 * kk + 8) * 144 + 32 * nn)));
            o.w = fp8x4_of_bf16x4(__builtin_amdgcn_ds_read_tr16_b64_v4i16((LAS s16x4_t*)(rp + (64 * kk + 12) * 144 + 32 * nn)));
            *(v4u*)(d + 64 * kk) = o; }
    }
    LDS_FENCE();
}

struct Ptrs {
    const float *x, *p, *norm1_g, *w_in, *four_w, *gmlp_ln_g, *gmlp_ln_b, *gmlp_ws, *gmlp_bs, *conv_w, *gate_b, *mnorm_g, *w_out, *norm2_g, *router_w, *router_b,
                *ew_gate, *ew_up, *ew_down, *sh_gate, *sh_up, *sh_down, *ple_w_in, *ple_w_gate, *ple_norm_g, *final_g;
    float* out; unsigned char* ws;
};
typedef const __attribute__((address_space(4))) unsigned char* kptr_t;
__device__ __forceinline__ void load_ptrs(Ptrs& P) {
    kptr_t k = (kptr_t)__builtin_amdgcn_kernarg_segment_ptr(); asm volatile("" : "+s"(k));
#define KP(i) (*(const float* const __attribute__((address_space(4)))*)(k + 8 * (i)))
    P.x = KP(0); P.p = KP(1); P.norm1_g = KP(2); P.w_in = KP(3); P.four_w = KP(4); P.gmlp_ln_g = KP(5); P.gmlp_ln_b = KP(6); P.gmlp_ws = KP(7); P.gmlp_bs = KP(8);
    P.conv_w = KP(9); P.gate_b = KP(10); P.mnorm_g = KP(11); P.w_out = KP(12); P.norm2_g = KP(13); P.router_w = KP(14); P.router_b = KP(15);
    P.ew_gate = KP(16); P.ew_up = KP(17); P.ew_down = KP(18); P.sh_gate = KP(19); P.sh_up = KP(20); P.sh_down = KP(21); P.ple_w_in = KP(22); P.ple_w_gate = KP(23);
    P.ple_norm_g = KP(24); P.final_g = KP(25); P.out = (float*)KP(26); P.ws = (unsigned char*)KP(27);
#undef KP
}

__device__ __forceinline__ void phase_p0a(const Ptrs& P, LAS unsigned char* lds, int tid_, int vcu, int G) {
    const int tid = otid(); (void)tid_;
    const int lane = tid & 63, wave = tid >> 6;
    LAS float* scr = (LAS float*)(lds + (wave < 7 ? wave * 18432 : LDS_ROWTAB));
    const int gw = vcu * NWAVES + wave, NGW = G * NWAVES;
    { LAS unsigned char* img = lds + (wave < 7 ? wave * 18432 : LDS_ROWTAB);
      constexpr int NI_E = 96, NI_EL = NE * NI_E;
      for (int it = gw; it < NL * NI_EL; it += NGW) {
        const int l = NL - 1 - it / NI_EL, r = it % NI_EL, e = r / NI_E, q = r % NI_E, mat = q >> 5, qq = q & 31;
        const size_t eo = ((size_t)l * NE + e) * 1024 * 256;
        if (mat < 2) transpose_item8<false>((mat ? P.ew_up : P.ew_gate) + eo, 256, 128 * (qq >> 2), 64 * (qq & 3), P.ws + WS_WGU + (size_t)l * WGU_L, e * 512 + 128 * mat, 1024, img, lane);
        else transpose_item8<true>(P.ew_down + eo, 1024, 128 * (qq >> 4), 64 * (qq & 15), P.ws + WS_WD + (size_t)l * WD_L + WD8_OFF, e * 1024, 256, img, lane);
      } }
    constexpr int NI_WIN = 1024, NI_WOUT = 512, NI_ROUT = 64, NI_PLEIN = 128, NI_PLEG = 512, NI_SH = 384, NI_EXP = 0, NI_L = NI_WIN + NI_WOUT + NI_ROUT + NI_PLEIN + NI_PLEG + NI_SH + NI_EXP;
    for (int it = gw; it < NL * NI_L; it += NGW) {
        const int l = NL - 1 - it / NI_L; int r = it % NI_L;
        if (r >= NI_L - NI_EXP - NI_SH) {
            r -= NI_L - NI_EXP - NI_SH;
            int eidx, q; const float *sg, *su, *sd;
            { eidx = 0; q = r; sg = P.sh_gate + (size_t)l * 1024 * 256; su = P.sh_up + (size_t)l * 1024 * 256; sd = P.sh_down + (size_t)l * 256 * 1024; }
            if (q < 256) { const int up = q >> 7, qq = q & 127, kb = qq >> 3, nb = qq & 7, n0 = 32 * nb, k0 = 64 * kb;
                if (eidx) {
                    unsigned char* d8 = P.ws + WS_WGU + (size_t)l * WGU_L + ((size_t)(eidx - 1) * 512 + 256 * (n0 >> 7) + (n0 & 127) + 128 * up) * 1024 + k0;
                    transpose_item(up ? su : sg, 256, k0, n0, (bf16*)d8, 1024, scr, lane, 0, 1);
                } else {
                    bf16* dst = (bf16*)(P.ws + WS_RS + (size_t)l * RS_L) + (size_t)256 * 1024 + ((size_t)256 * (n0 >> 7) + (n0 & 127) + 128 * up) * 1024 + k0;
                    transpose_item(up ? su : sg, 256, k0, n0, dst, 1024, scr, lane); } }
            else { const int qq = q - 256, kb = qq >> 5, nb = qq & 31, n0 = 32 * nb, k0 = 64 * kb;
                if (eidx) { unsigned char* d8 = P.ws + WS_WD + (size_t)l * WD_L + WD8_OFF + ((size_t)(eidx - 1) * 1024 + n0) * 256 + k0;
                    transpose_item(sd, 1024, k0, n0, (bf16*)d8, 256, scr, lane, 1, 1); }
                else { bf16* dst = (bf16*)(P.ws + WS_WD + (size_t)l * WD_L) + (size_t)n0 * 256 + k0; transpose_item(sd, 1024, k0, n0, dst, 256, scr, lane, 0); } }
            continue;
        }
        if (r < NI_WIN) { const int kb = r >> 6, nb = r & 63;
            transpose_item(P.w_in + (size_t)l * 1024 * DIN, DIN, 64 * kb, 256 + 32 * nb, (bf16*)(P.ws + WS_WIN) + ((size_t)l * 2048 + 32 * nb) * 1024 + 64 * kb, 1024, scr, lane); continue; }
        r -= NI_WIN;
        if (r < NI_WOUT) { const int kb = r >> 5, nb = r & 31;
            transpose_item(P.w_out + (size_t)l * 1024 * 1024, 1024, 64 * kb, 32 * nb, (bf16*)(P.ws + WS_WOUT) + ((size_t)l * 1024 + 32 * nb) * 1024 + 64 * kb, 1024, scr, lane); continue; }
        r -= NI_WOUT;
        if (r < NI_ROUT) { const int kb = r >> 2, nb = r & 3;
            transpose_item(P.router_w + (size_t)l * 1024 * 128, 128, 64 * kb, 32 * nb, (bf16*)(P.ws + WS_RS + (size_t)l * RS_L) + ((size_t)32 * nb) * 1024 + 64 * kb, 1024, scr, lane); continue; }
        r -= NI_ROUT;
        if (r < NI_PLEIN) { const int kb = r >> 5, nb = r & 31;
            transpose_item(P.ple_w_in + (size_t)l * 256 * 1024, 1024, 64 * kb, 32 * nb, (bf16*)(P.ws + WS_PLEIN) + ((size_t)l * 1024 + 32 * nb) * 256 + 64 * kb, 256, scr, lane); continue; }
        r -= NI_PLEIN;
        { const int kb = r >> 5, nb = r & 31;
            transpose_item(P.ple_w_gate + (size_t)l * 1024 * 1024, 1024, 64 * kb, 32 * nb, (bf16*)(P.ws + WS_PLEG) + ((size_t)l * 1024 + 32 * nb) * 1024 + 64 * kb, 1024, scr, lane); }
    }
    const size_t gt = (size_t)vcu * NTHR + tid, NGT = (size_t)G * NTHR;
    for (size_t i = gt; i < (size_t)NL * 128 * 1024 / 8; i += NGT) { const size_t l = i / (128 * 128), r = i % (128 * 128); *(v4u*)((bf16*)(P.ws + WS_RS + l * RS_L) + (size_t)128 * 1024 + r * 8) = (v4u){0u, 0u, 0u, 0u}; }
    for (size_t i = gt; i < (size_t)NL * 4 * 128 * 128 / 2; i += NGT) { const float a = P.gmlp_ws[2 * i], b = P.gmlp_ws[2 * i + 1]; ((unsigned*)(P.ws + WS_GWS))[i] = pk2(a, b); }
    for (size_t i = gt; i < (size_t)2048 * 2048 / 8; i += NGT) { const int so = (int)(i >> 8), k8 = (int)(i & 255) * 8; float v[8];
#pragma unroll
        for (int j = 0; j < 8; ++j) { const int kk = k8 + j, sx = kk & 1023; const int mm = (so * sx) & 2047; const float ang = (float)mm * (1.0f / 1024.0f);
            v[j] = (kk < 1024) ? cospif(ang) : ((kk == 1024) ? ((so & 1) ? -1.f : 1.f) : -sinpif(ang)); }
        v4u w; w.x = pk2(v[0], v[1]); w.y = pk2(v[2], v[3]); w.z = pk2(v[4], v[5]); w.w = pk2(v[6], v[7]); ((v4u*)(P.ws + WS_DFT))[i] = w; }
    for (size_t i = gt; i < (size_t)NL * T * 256 / 8; i += NGT) { const f32x4 a = __builtin_nontemporal_load((const f32x4*)P.p + 2 * i), b = __builtin_nontemporal_load((const f32x4*)P.p + 2 * i + 1);
        v4u w; w.x = pk2(a[0], a[1]); w.y = pk2(a[2], a[3]); w.z = pk2(b[0], b[1]); w.w = pk2(b[2], b[3]); ((v4u*)(P.ws + WS_PB))[i] = w; }
    for (size_t i = gt; i < (size_t)NL * 2 * 4 * 64 * 64; i += NGT) { const int e = (int)(i & 63), d = (int)((i >> 6) & 63), h = (int)((i >> 12) & 3), kind = (int)((i >> 14) & 1), l = (int)(i >> 15);
        const float* fw = P.four_w + ((size_t)(l * 4 + h) * 64) * 64 + e; float s = 0.f;
        for (int kp = 0; kp < 64; ++kp) { const float ang = (float)((kp * d) & 63) * (1.0f / 32.0f); s += (kind ? sinpif(ang) : cospif(ang)) * fw[kp * 64]; }
        ((float*)(P.ws + WS_CSW))[i] = s * 0.00276213586f; }
}

__device__ __forceinline__ void phase_p0b_fold(const Ptrs& P, LAS unsigned char* lds, int tid_, int vcu, int G) {
    const int tid = otid(); (void)tid_;
    LAS float* cs = (LAS float*)lds;
    for (int item = vcu; item < NL * 2 * 4 * 4 * 2; item += G) {
        const int ih = item & 1, eg = (item >> 1) & 3, h = (item >> 3) & 3, kind = (item >> 5) & 1, l = item >> 6;
        const float* csg = (const float*)(P.ws + WS_CSW) + ((size_t)((l * 2 + kind) * 4 + h) * 64) * 64 + eg * 16;
        __syncthreads();
        for (int q = tid; q < 1024; q += NTHR) cs[q] = csg[(q >> 4) * 64 + (q & 15)];
        __syncthreads();
        const int i = ih * 512 + tid;
        const float* wr = P.w_in + ((size_t)l * 1024 + i) * DIN + h * 64;
        float acc[16];
#pragma unroll
        for (int e = 0; e < 16; ++e) acc[e] = 0.f;
#pragma unroll 4
        for (int d4 = 0; d4 < 16; ++d4) { const f32x4 xv = *(const f32x4*)(wr + 4 * d4);
#pragma unroll
            for (int dd = 0; dd < 4; ++dd) { const LAS f32x4* cr = (const LAS f32x4*)(cs + (4 * d4 + dd) * 16);
#pragma unroll
                for (int e4 = 0; e4 < 4; ++e4) { const f32x4 c = cr[e4]; acc[4 * e4] += xv[dd] * c[0]; acc[4 * e4 + 1] += xv[dd] * c[1]; acc[4 * e4 + 2] += xv[dd] * c[2]; acc[4 * e4 + 3] += xv[dd] * c[3]; } } }
        bf16* dst = (bf16*)(P.ws + WS_WPQ) + ((size_t)l * 512 + kind * 256 + h * 64 + eg * 16) * 1024 + i;
#pragma unroll
        for (int e = 0; e < 16; ++e) dst[(size_t)e * 1024] = (bf16)f2bf(acc[e]);
    }
    __syncthreads();
}

template <int MODE>
__device__ __forceinline__ void phase_rowpass1(const Ptrs& P, LAS unsigned char* lds, int layer, int tid_, int vcu, int G) {
    const int tid = otid(); (void)tid_;
    const int lane = tid & 63, wave = tid >> 6, gw = vcu * NWAVES + wave, NGW = G * NWAVES;
    LAS float* gwt = (LAS float*)lds;
    if (MODE != 2) {
        for (int idx = tid; idx < 4096; idx += NTHR) { const int k = idx >> 2, q = idx & 3; const f32x4 v = *(const f32x4*)(P.w_in + ((size_t)layer * 1024 + k) * DIN + 2304 + 4 * q);
            gwt[(4 * q + 0) * 1024 + k] = v[0]; gwt[(4 * q + 1) * 1024 + k] = v[1]; gwt[(4 * q + 2) * 1024 + k] = v[2]; gwt[(4 * q + 3) * 1024 + k] = v[3]; }
        __syncthreads();
    }
    float* H = (float*)(P.ws + WS_H); const bf16* GE = (const bf16*)(P.ws + WS_GE);
    const float* pg = P.ple_norm_g + (size_t)(layer - 1) * D;
    const float* g1 = (MODE == 2) ? P.final_g : P.norm1_g + (size_t)layer * D;
    for (int row = gw; row < T; row += NGW) {
        f32x4 v[4];
        if (MODE == 0) {
#pragma unroll
            for (int j = 0; j < 4; ++j) v[j] = ((const f32x4*)(P.x + (size_t)row * D))[lane + 64 * j];
        } else {
            f32x4 e[4]; float ss = 0.f;
#pragma unroll
            for (int j = 0; j < 4; ++j) { v[j] = ((const f32x4*)(H + (size_t)row * D))[lane + 64 * j]; const v2u w = __builtin_nontemporal_load((const v2u*)(GE + (size_t)row * D) + lane + 64 * j);
                e[j] = (f32x4){bflo(w.x), bfhi(w.x), bflo(w.y), bfhi(w.y)}; ss += e[j][0] * e[j][0] + e[j][1] * e[j][1] + e[j][2] * e[j][2] + e[j][3] * e[j][3]; }
            const float r = rsqrtf(wave_sum(ss) * (1.f / D) + EPS);
#pragma unroll
            for (int j = 0; j < 4; ++j) { const f32x4 g = ((const f32x4*)pg)[lane + 64 * j]; v[j] = v[j] + e[j] * r * g; }
        }
        if (MODE != 2) {
#pragma unroll
            for (int j = 0; j < 4; ++j) ((f32x4*)(H + (size_t)row * D))[lane + 64 * j] = v[j];
        }
        float ss = 0.f;
#pragma unroll
        for (int j = 0; j < 4; ++j) ss += v[j][0] * v[j][0] + v[j][1] * v[j][1] + v[j][2] * v[j][2] + v[j][3] * v[j][3];
        const float rstd = rsqrtf(wave_sum(ss) * (1.f / D) + EPS);
#pragma unroll
        for (int j = 0; j < 4; ++j) { const f32x4 g = ((const f32x4*)g1)[lane + 64 * j]; v[j] = v[j] * rstd * g; }
        if (MODE == 2) {
#pragma unroll
            for (int j = 0; j < 4; ++j) ((f32x4*)(P.out + (size_t)row * D))[lane + 64 * j] = v[j];
        } else {
            bf16* A = (bf16*)(P.ws + WS_XM) + (size_t)row * D;
#pragma unroll
            for (int j = 0; j < 4; ++j) { v2u w; w.x = pk2(v[j][0], v[j][1]); w.y = pk2(v[j][2], v[j][3]); ((v2u*)A)[lane + 64 * j] = w; }
            float pg[16];
#pragma unroll
            for (int g = 0; g < 16; ++g) { float s = 0.f;
#pragma unroll
                for (int j = 0; j < 4; ++j) { const f32x4 w = *(const LAS f32x4*)(gwt + g * 1024 + 4 * (lane + 64 * j)); s += v[j][0] * w[0] + v[j][1] * w[1] + v[j][2] * w[2] + v[j][3] * w[3]; }
                pg[g] = s; }
            float p8[8], p4[4], p2[2], p1;
            { const bool hi = (lane & 32) != 0;
#pragma unroll
              for (int i = 0; i < 8; ++i) { const float send = hi ? pg[i] : pg[8 + i], keep = hi ? pg[8 + i] : pg[i]; p8[i] = keep + __shfl_xor(send, 32); } }
            { const bool hi = (lane & 16) != 0;
#pragma unroll
              for (int i = 0; i < 4; ++i) { const float send = hi ? p8[i] : p8[4 + i], keep = hi ? p8[4 + i] : p8[i]; p4[i] = keep + __shfl_xor(send, 16); } }
            { const bool hi = (lane & 8) != 0;
#pragma unroll
              for (int i = 0; i < 2; ++i) { const float send = hi ? p4[i] : p4[2 + i], keep = hi ? p4[2 + i] : p4[i]; p2[i] = keep + __shfl_xor(send, 8); } }
            { const bool hi = (lane & 4) != 0; const float send = hi ? p2[0] : p2[1], keep = hi ? p2[1] : p2[0]; p1 = keep + __shfl_xor(send, 4); }
            p1 += __shfl_xor(p1, 2); p1 += __shfl_xor(p1, 1);
            const int src = (((lane >> 3) & 1) << 5) | (((lane >> 2) & 1) << 4) | (((lane >> 1) & 1) << 3) | ((lane & 1) << 2);
            const float mine = __shfl(p1, src);
            if (lane < 16) { float gv = mine + P.gate_b[layer * 16 + lane]; if ((lane >> 2) & 1) gv = logsigf_(gv); ((float*)(P.ws + WS_GATES))[(size_t)row * 16 + lane] = gv; }
        }
    }
}
__device__ __forceinline__ void phase_rowpass2(const Ptrs& P, int layer, int tid_, int vcu, int G) {
    const int tid = otid(); (void)tid_;
    const int lane = tid & 63, wave = tid >> 6, gw = vcu * NWAVES + wave, NGW = G * NWAVES;
    const float* H = (const float*)(P.ws + WS_H); const float* g2 = P.norm2_g + (size_t)layer * D;
    for (int row = gw; row < T; row += NGW) {
        f32x4 v[4]; float ss = 0.f;
#pragma unroll
        for (int j = 0; j < 4; ++j) { v[j] = ((const f32x4*)(H + (size_t)row * D))[lane + 64 * j]; ss += v[j][0] * v[j][0] + v[j][1] * v[j][1] + v[j][2] * v[j][2] + v[j][3] * v[j][3]; }
        const float rstd = rsqrtf(wave_sum(ss) * (1.f / D) + EPS);
        bf16* A = (bf16*)(P.ws + WS_XM) + (size_t)row * D;
#pragma unroll
        for (int j = 0; j < 4; ++j) { const f32x4 g = ((const f32x4*)g2)[lane + 64 * j]; const float x0 = v[j][0] * rstd * g[0], x1 = v[j][1] * rstd * g[1], x2 = v[j][2] * rstd * g[2], x3 = v[j][3] * rstd * g[3];
            v2u w; w.x = pk2(x0, x1); w.y = pk2(x2, x3); ((v2u*)A)[lane + 64 * j] = w;
            ((unsigned*)(P.ws + WS_XM8 + (size_t)row * D))[lane + 64 * j] = (unsigned)__builtin_amdgcn_cvt_pk_fp8_f32(x2 * SX8, x3 * SX8, __builtin_amdgcn_cvt_pk_fp8_f32(x0 * SX8, x1 * SX8, 0, false), true); }
    }
}
__device__ __forceinline__ void phase_combine(const Ptrs& P, int tid_, int vcu, int G) {
    const int tid = otid(); (void)tid_;
    const int lane = tid & 63, wave = tid >> 6, gw = vcu * NWAVES + wave, NGW = G * NWAVES;
    float* H = (float*)(P.ws + WS_H); const bf16* YS = (const bf16*)(P.ws + WS_Y); const unsigned char* Y8 = (const unsigned char*)(P.ws + WS_Y) + (size_t)T * 1024 * 2; bf16* HB = (bf16*)(P.ws + WS_HB);
    const float* tg = (const float*)(P.ws + WS_TOPK);
    for (int t = gw; t < T; t += NGW) {
        float v[16]; v4u ys[2], yk[8];
        const f32x4* hp = (const f32x4*)(H + (size_t)t * D) + 4 * lane; const v4u* ysp = (const v4u*)(YS + (size_t)t * D) + 2 * lane; const v4u* yr = (const v4u*)(Y8 + (size_t)t * 8 * 1024) + lane;
        float mg = 0.f; if (lane < 8) mg = tg[(size_t)t * 8 + lane] * (1.f / 16.f);
#pragma unroll
        for (int q = 0; q < 4; ++q) { const f32x4 a = hp[q]; v[4 * q] = a[0]; v[4 * q + 1] = a[1]; v[4 * q + 2] = a[2]; v[4 * q + 3] = a[3]; }
        ys[0] = __builtin_nontemporal_load(ysp); ys[1] = __builtin_nontemporal_load(ysp + 1);
#pragma unroll
        for (int k = 0; k < 8; ++k) yk[k] = __builtin_nontemporal_load(yr + k * 64);
#pragma unroll
        for (int jj = 0; jj < 2; ++jj) { const unsigned w[4] = {ys[jj].x, ys[jj].y, ys[jj].z, ys[jj].w};
#pragma unroll
            for (int i = 0; i < 4; ++i) { v[8 * jj + 2 * i] += bflo(w[i]); v[8 * jj + 2 * i + 1] += bfhi(w[i]); } }
#pragma unroll
        for (int k = 0; k < 8; ++k) { const float g = __shfl(mg, k); const unsigned w[4] = {yk[k].x, yk[k].y, yk[k].z, yk[k].w};
#pragma unroll
            for (int i = 0; i < 4; ++i) { const auto lo = __builtin_amdgcn_cvt_pk_f32_fp8((int)w[i], false); const auto hi = __builtin_amdgcn_cvt_pk_f32_fp8((int)w[i], true);
                v[4 * i] += g * lo[0]; v[4 * i + 1] += g * lo[1]; v[4 * i + 2] += g * hi[0]; v[4 * i + 3] += g * hi[1]; } }
        f32x4* ho = (f32x4*)(H + (size_t)t * D) + 4 * lane;
#pragma unroll
        for (int q = 0; q < 4; ++q) ho[q] = (f32x4){v[4 * q], v[4 * q + 1], v[4 * q + 2], v[4 * q + 3]};
        v4u w0, w1; w0.x = pk2(v[0], v[1]); w0.y = pk2(v[2], v[3]); w0.z = pk2(v[4], v[5]); w0.w = pk2(v[6], v[7]); w1.x = pk2(v[8], v[9]); w1.y = pk2(v[10], v[11]); w1.z = pk2(v[12], v[13]); w1.w = pk2(v[14], v[15]);
        v4u* hbo = (v4u*)(HB + (size_t)t * D) + 2 * lane; hbo[0] = w0; hbo[1] = w1;
    }
}

struct ZR6 { v4u c0, c1, p0, p1, n0, n1; };
__device__ __forceinline__ ZR6 conv_load(const bf16* z, int trow, int sg, int zcol) {
    const bf16* zr = z + (size_t)trow * 2048 + zcol; ZR6 r;
    r.c0 = *(const v4u*)zr; r.c1 = *(const v4u*)(zr + 8); r.p0 = (v4u){0u, 0u, 0u, 0u}; r.p1 = r.p0; r.n0 = r.p0; r.n1 = r.p0;
    if (sg > 0) { r.p0 = *(const v4u*)(zr - 2048); r.p1 = *(const v4u*)(zr - 2048 + 8); }
    if (sg < SEQ - 1) { r.n0 = *(const v4u*)(zr + 2048); r.n1 = *(const v4u*)(zr + 2048 + 8); }
    return r;
}
__device__ __forceinline__ void conv_compute(const ZR6& r, const float* cw, int wcol, float (&o)[16]) {
    const unsigned pw[8] = {r.p0.x, r.p0.y, r.p0.z, r.p0.w, r.p1.x, r.p1.y, r.p1.z, r.p1.w}, cwd[8] = {r.c0.x, r.c0.y, r.c0.z, r.c0.w, r.c1.x, r.c1.y, r.c1.z, r.c1.w}, nw[8] = {r.n0.x, r.n0.y, r.n0.z, r.n0.w, r.n1.x, r.n1.y, r.n1.z, r.n1.w};
    float w0[16], w1[16], w2[16];
#pragma unroll
    for (int q = 0; q < 4; ++q) { const f32x4 a0 = *(const f32x4*)(cw + wcol + 4 * q), a1 = *(const f32x4*)(cw + 512 + wcol + 4 * q), a2 = *(const f32x4*)(cw + 1024 + wcol + 4 * q);
#pragma unroll
        for (int j = 0; j < 4; ++j) { w0[4 * q + j] = a0[j]; w1[4 * q + j] = a1[j]; w2[4 * q + j] = a2[j]; } }
#pragma unroll
    for (int i = 0; i < 8; ++i) {
        o[2 * i] = siluf_(w0[2 * i] * bflo(pw[i]) + w1[2 * i] * bflo(cwd[i]) + w2[2 * i] * bflo(nw[i]));
        o[2 * i + 1] = siluf_(w0[2 * i + 1] * bfhi(pw[i]) + w1[2 * i + 1] * bfhi(cwd[i]) + w2[2 * i + 1] * bfhi(nw[i])); }
}
__device__ __forceinline__ void conv16(const bf16* z, const float* cw, int trow, int sg, int zcol, int wcol, float (&o)[16]) { const ZR6 r = conv_load(z, trow, sg, zcol); conv_compute(r, cw, wcol, o); }
struct VR4 { v4u q[4]; };
__device__ __forceinline__ VR4 vT_load(const bf16* z, int t0, int hh, int tid) { const int s = tid >> 2, part = tid & 3; const bf16* src = z + (size_t)(t0 + s) * 2048 + 1024 + hh * 128 + part * 32; VR4 r;
#pragma unroll
    for (int q = 0; q < 4; ++q) r.q[q] = *(const v4u*)(src + 8 * q);
    return r; }
__device__ __forceinline__ void vT_store(LAS unsigned char* VT, const VR4& r, int tid) { const int s = tid >> 2, part = tid & 3;
#pragma unroll
    for (int q = 0; q < 4; ++q) { const unsigned ww[4] = {r.q[q].x, r.q[q].y, r.q[q].z, r.q[q].w};
#pragma unroll
        for (int i = 0; i < 4; ++i) { const int e = part * 32 + q * 8 + 2 * i; *(LAS bf16*)(VT + e * 272 + s * 2) = (bf16)(ww[i] & 0xffffu); *(LAS bf16*)(VT + (e + 1) * 272 + s * 2) = (bf16)(ww[i] >> 16); } } }
__device__ __forceinline__ void stage_vT(LAS unsigned char* VT, const bf16* z, int t0, int hh, int tid) {
    const int s = tid >> 2, part = tid & 3; const bf16* src = z + (size_t)(t0 + s) * 2048 + 1024 + hh * 128 + part * 32;
#pragma unroll
    for (int q = 0; q < 4; ++q) { const v4u w = *(const v4u*)(src + 8 * q); const unsigned ww[4] = {w.x, w.y, w.z, w.w};
#pragma unroll
        for (int i = 0; i < 4; ++i) { const int e = part * 32 + q * 8 + 2 * i; *(LAS bf16*)(VT + e * 272 + s * 2) = (bf16)(ww[i] & 0xffffu); *(LAS bf16*)(VT + (e + 1) * 272 + s * 2) = (bf16)(ww[i] >> 16); } }
}


__device__ __forceinline__ float shfl_up_l(float v, int off, int lane) { return __int_as_float(__builtin_amdgcn_ds_bpermute(((lane - off) & 63) << 2, __float_as_int(v))); }
__device__ __forceinline__ float shfl_l(float v, int src) { return __int_as_float(__builtin_amdgcn_ds_bpermute(src << 2, __float_as_int(v))); }
__device__ __forceinline__ void gate_scan(const LAS float* li, LAS float* lf, int dir, int lane, int (&pos)[2], float (&b)[2], float (&x)[2], float& g) {
    pos[0] = dir ? 127 - 2 * lane : 2 * lane; pos[1] = dir ? 126 - 2 * lane : 2 * lane + 1;
    const float f0 = lf[pos[0]], f1 = lf[pos[1]]; const float s1 = f0 + f1; float inc = s1;
#pragma unroll
    for (int off = 1; off < 64; off <<= 1) { const float y = shfl_up_l(inc, off, lane); if (lane >= off) inc += y; }
    const float exc = inc - s1; b[0] = exc + f0; b[1] = exc + s1; g = shfl_l(inc, 63);
    lf[pos[0]] = b[0]; lf[pos[1]] = b[1];
    x[0] = li[pos[0]] - b[0]; x[1] = li[pos[1]] - b[1];
}

__device__ __forceinline__ void m1_unit(LAS unsigned char* L, int u, const bf16* z, const float* gates, const float* cw, float* cloc, float* nloc, float* mg, int tid_) {
    const int tid = otid(); (void)tid_;
    constexpr int VT = 0, KWF = 34816, KWB = 52224, GA = 69632;
    const int lane = tid & 63, w = tid >> 6, fr = lane & 15, fq = lane >> 4;
    const int c = u & 15, hh = (u >> 4) & 3, b = u >> 6, t0 = b * SEQ + c * 128;
    LAS float* ga = (LAS float*)(L + GA);
    const VR4 vr = vT_load(z, t0, hh, tid);
    const ZR6 zk = conv_load(z, t0 + (tid >> 2), c * 128 + (tid >> 2), 768 + hh * 64 + (tid & 3) * 16);
    if (tid < 128) { const float* g = gates + (size_t)(t0 + tid) * 16; ga[tid] = g[hh]; ga[128 + tid] = g[4 + hh]; ga[256 + tid] = g[8 + hh]; ga[384 + tid] = g[12 + hh]; }
    vT_store(L + VT, vr, tid);
    __syncthreads();
    if (w < 2) {
        const int dir = w; LAS float* li = ga + dir * 256; LAS float* lf = li + 128; LAS float* wo = ga + 512 + dir * 128;
        int pos[2]; float bq[2], xq[2], g; gate_scan(li, lf, dir, lane, pos, bq, xq, g);
        float a0 = g + xq[0], a1 = g + xq[1], m = fmaxf(a0, a1);
#pragma unroll
        for (int off = 1; off < 64; off <<= 1) m = fmaxf(m, __shfl_xor(m, off));
        wo[pos[0]] = __expf(a0 - m); wo[pos[1]] = __expf(a1 - m);
        if (lane == 0) { mg[((size_t)dir * 512 + u) * 2 + 0] = m; mg[((size_t)dir * 512 + u) * 2 + 1] = g; }
    }
    __syncthreads();
    { const int s = tid >> 2, part = tid & 3; float k[16]; conv_compute(zk, cw, 256 + hh * 64 + part * 16, k);
      const float wF = ga[512 + s], wB = ga[640 + s];
#pragma unroll
      for (int i = 0; i < 16; ++i) { const int d = part * 16 + i; *(LAS bf16*)(L + KWF + d * 272 + s * 2) = (bf16)f2bf(wF * k[i]); *(LAS bf16*)(L + KWB + d * 272 + s * 2) = (bf16)f2bf(wB * k[i]); } }
    __syncthreads();
    { const int dir = w >> 2, wq = w & 3; LAS unsigned char* KW = L + (dir ? KWB : KWF);
      f32x4 acc[2][4];
#pragma unroll
      for (int mt = 0; mt < 2; ++mt)
#pragma unroll
          for (int nt = 0; nt < 4; ++nt) acc[mt][nt] = (f32x4){0.f, 0.f, 0.f, 0.f};
#pragma unroll
      for (int ks = 0; ks < 4; ++ks) { bf16x8 a[2];
#pragma unroll
          for (int mt = 0; mt < 2; ++mt) a[mt] = *(const LAS bf16x8*)(L + VT + (32 * wq + mt * 16 + fr) * 272 + ks * 64 + fq * 16);
#pragma unroll
          for (int nt = 0; nt < 4; ++nt) { const bf16x8 bk = *(const LAS bf16x8*)(KW + (nt * 16 + fr) * 272 + ks * 64 + fq * 16);
#pragma unroll
              for (int mt = 0; mt < 2; ++mt) acc[mt][nt] = MFMA16(a[mt], bk, acc[mt][nt]); } }
      float* co = cloc + ((size_t)dir * 512 + u) * 8192;
#pragma unroll
      for (int mt = 0; mt < 2; ++mt)
#pragma unroll
          for (int nt = 0; nt < 4; ++nt)
#pragma unroll
              for (int r = 0; r < 4; ++r) co[(32 * wq + mt * 16 + 4 * fq + r) * 64 + nt * 16 + fr] = acc[mt][nt][r]; }
    if (tid < 128) { const int dir = tid >> 6, d = tid & 63; const LAS unsigned char* KW = L + (dir ? KWB : KWF) + d * 272; float s = 0.f;
        for (int q = 0; q < 16; ++q) { const v4u w4 = *(const LAS v4u*)(KW + q * 16); s += bflo(w4.x) + bfhi(w4.x) + bflo(w4.y) + bfhi(w4.y) + bflo(w4.z) + bfhi(w4.z) + bflo(w4.w) + bfhi(w4.w); }
        nloc[((size_t)dir * 512 + u) * 64 + d] = s; }
    __syncthreads();
}

__device__ __forceinline__ void phase_m2(const Ptrs& P, int tid_, int vcu, int G) {
    const int tid = otid(); (void)tid_;
    const float* cloc = (const float*)(P.ws + WS_CLOC); bf16* cprev = (bf16*)(P.ws + WS_CPREV);
    float* sm = (float*)(P.ws + WS_SMALL); const float* nloc = sm; float* nprev = sm + 65536; const float* mg = sm + 131072; float* mprev = sm + 131072 + 2048;
    for (int it = vcu; it < 64 * 17; it += G) {
        const int seq = it / 17, blk = it % 17, dir = seq >> 5, bh = seq & 31;
        if (blk == 16 && tid >= 64) continue;
        float loc[16], ml[16], gg[16];
#pragma unroll
        for (int step = 0; step < 16; ++step) {
            const int c = dir ? 15 - step : step; const size_t du = (size_t)dir * 512 + bh * 16 + c;
            ml[step] = mg[du * 2]; gg[step] = mg[du * 2 + 1];
            loc[step] = (blk < 16) ? __builtin_nontemporal_load(cloc + du * 8192 + blk * 512 + tid) : nloc[du * 64 + tid];
        }
        float m = 0.f, st = 0.f;
#pragma unroll
        for (int step = 0; step < 16; ++step) {
            const int c = dir ? 15 - step : step; const size_t du = (size_t)dir * 512 + bh * 16 + c;
            if (blk < 16) cprev[du * 8192 + blk * 512 + tid] = (bf16)f2bf(st);
            else { nprev[du * 64 + tid] = st; if (tid == 0) mprev[du] = m; }
            const float mn = fmaxf(gg[step] + m, ml[step]), ao = __expf(gg[step] + m - mn), an = __expf(ml[step] - mn);
            st = ao * st + an * loc[step]; m = mn;
        }
    }
}

__device__ __forceinline__ void phase_pqfold(const Ptrs& P, int tid_, int vcu, int G) {
    const int tid = otid(); (void)tid_;
    const bf16* PQ = (const bf16*)(P.ws + WS_PQT); bf16* PF = (bf16*)(P.ws + WS_PQF);
    const size_t gt = (size_t)vcu * NTHR + tid, NGT = (size_t)G * NTHR;
    for (size_t i = gt; i < (size_t)2048 * 2048 / 8; i += NGT) { const int row = (int)(i >> 8), k8 = (int)(i & 255) * 8; const bool sinpart = k8 >= 1024; const int s8 = k8 & 1023;
        const bf16* src = PQ + (size_t)row * 4096 + (sinpart ? 2048 : 0);
        const v4u f = *(const v4u*)(src + s8); const unsigned fw[4] = {f.x, f.y, f.z, f.w}; float v[8];
#pragma unroll
        for (int j = 0; j < 8; ++j) { const int sx = s8 + j; const float a = (j & 1) ? bfhi(fw[j >> 1]) : bflo(fw[j >> 1]); const float r = (sx > 0) ? bf2f(src[2048 - sx]) : 0.f;
            v[j] = sinpart ? ((sx > 0) ? a - r : bf2f(PQ[(size_t)row * 4096 + 1024])) : a + r; }
        v4u w; w.x = pk2(v[0], v[1]); w.y = pk2(v[2], v[3]); w.z = pk2(v[4], v[5]); w.w = pk2(v[6], v[7]); ((v4u*)PF)[i] = w; }
}

template <int DIR>
__device__ __forceinline__ void m3_dir(LAS unsigned char* L, const LAS float* ga, const f32x4 (&S)[8], const bf16x8 (&aq)[2], const bf16x8 (&cpf)[8][2], f32x4 npv, float mp, f32x4 (&acc)[8], float (&inter)[4], float (&mt)[4], float (&rs)[4], int w, int lane) {
    constexpr int QS = 0, SM = 71680;
    const int fr = lane & 15, fq = lane >> 4;
    const LAS float* li = ga + DIR * 384; const LAS float* bb = li + 128; const LAS float* pm = li + 256;
    float bj[4];
#pragma unroll
    for (int r = 0; r < 4; ++r) { const int j = 16 * w + 4 * fq + r; bj[r] = bb[j]; mt[r] = fmaxf(bj[r] + pm[j], bj[r] + mp); inter[r] = __expf(bj[r] + mp - mt[r]); rs[r] = 0.f; }
#pragma unroll
    for (int nt = 0; nt < 8; ++nt) { const int s = nt * 16 + fr; const float xs = li[s] - bb[s];
#pragma unroll
        for (int r = 0; r < 4; ++r) { const int j = 16 * w + 4 * fq + r; const bool valid = DIR ? (s >= j) : (s <= j);
            const float pv = valid ? __expf(bj[r] + xs - mt[r]) * S[nt][r] : 0.f; rs[r] += pv; *(LAS bf16*)(L + SM + j * 272 + s * 2) = (bf16)pk2(pv, 0.f); } }
#pragma unroll
    for (int r = 0; r < 4; ++r) { rs[r] += __shfl_xor(rs[r], 1); rs[r] += __shfl_xor(rs[r], 2); rs[r] += __shfl_xor(rs[r], 4); rs[r] += __shfl_xor(rs[r], 8); }
    LDS_FENCE();
#pragma unroll
    for (int nt = 0; nt < 8; ++nt) { f32x4 a = {0.f, 0.f, 0.f, 0.f};
#pragma unroll
        for (int ks = 0; ks < 2; ++ks) a = MFMA16(aq[ks], cpf[nt][ks], a);
#pragma unroll
        for (int r = 0; r < 4; ++r) a[r] *= inter[r];
        acc[nt] = a; }
    { const f32x4 np = npv;
#pragma unroll
      for (int r = 0; r < 4; ++r) { const int j = 16 * w + 4 * fq + r; const v2u qw = *(const LAS v2u*)(L + QS + j * 144 + fr * 8);
          float qn = bflo(qw.x) * np[0] + bfhi(qw.x) * np[1] + bflo(qw.y) * np[2] + bfhi(qw.y) * np[3];
          qn += __shfl_xor(qn, 1); qn += __shfl_xor(qn, 2); qn += __shfl_xor(qn, 4); qn += __shfl_xor(qn, 8);
          rs[r] = rs[r] + inter[r] * qn; } }
}
__device__ __forceinline__ void m3_pv(LAS unsigned char* L, f32x4 (&acc)[8], int w, int lane) {
    constexpr int VT = 36864, SM = 71680; const int fr = lane & 15, fq = lane >> 4;
#pragma unroll
    for (int ks = 0; ks < 4; ++ks) { const bf16x8 ap = *(const LAS bf16x8*)(L + SM + (16 * w + fr) * 272 + ks * 64 + fq * 16);
#pragma unroll
        for (int nt = 0; nt < 8; ++nt) { const bf16x8 bv = *(const LAS bf16x8*)(L + VT + (nt * 16 + fr) * 272 + ks * 64 + fq * 16); acc[nt] = MFMA16(ap, bv, acc[nt]); } }
}
__device__ __forceinline__ void m3_unit(LAS unsigned char* L, int u, const bf16* z, const float* gates, const float* cw, const bf16* cprev, const float* nprev, const float* mprev, const float* normg, bf16* mix, int tid_) {
    const int tid = otid(); (void)tid_;
    constexpr int QS = 0, KS = 18432, VT = 36864, GA = 106496;
    const int lane = tid & 63, w = tid >> 6, fr = lane & 15, fq = lane >> 4;
    const int c = u & 15, hh = (u >> 4) & 3, b = u >> 6, t0 = b * SEQ + c * 128;
    LAS float* ga = (LAS float*)(L + GA);
    const ZR6 zq = conv_load(z, t0 + (tid >> 2), c * 128 + (tid >> 2), 512 + hh * 64 + (tid & 3) * 16);
    const ZR6 zk = conv_load(z, t0 + (tid >> 2), c * 128 + (tid >> 2), 768 + hh * 64 + (tid & 3) * 16);
    const VR4 vr = vT_load(z, t0, hh, tid);
    if (tid < 128) { const float* g = gates + (size_t)(t0 + tid) * 16; ga[tid] = g[hh]; ga[128 + tid] = g[4 + hh]; ga[384 + tid] = g[8 + hh]; ga[512 + tid] = g[12 + hh]; }
    { const int s = tid >> 2, part = tid & 3; float o[16];
      conv_compute(zq, cw, hh * 64 + part * 16, o);
      v4u w0, w1; w0.x = pk2(o[0] * 0.125f, o[1] * 0.125f); w0.y = pk2(o[2] * 0.125f, o[3] * 0.125f); w0.z = pk2(o[4] * 0.125f, o[5] * 0.125f); w0.w = pk2(o[6] * 0.125f, o[7] * 0.125f);
      w1.x = pk2(o[8] * 0.125f, o[9] * 0.125f); w1.y = pk2(o[10] * 0.125f, o[11] * 0.125f); w1.z = pk2(o[12] * 0.125f, o[13] * 0.125f); w1.w = pk2(o[14] * 0.125f, o[15] * 0.125f);
      *(LAS v4u*)(L + QS + s * 144 + part * 32) = w0; *(LAS v4u*)(L + QS + s * 144 + part * 32 + 16) = w1;
      conv_compute(zk, cw, 256 + hh * 64 + part * 16, o);
      w0.x = pk2(o[0], o[1]); w0.y = pk2(o[2], o[3]); w0.z = pk2(o[4], o[5]); w0.w = pk2(o[6], o[7]); w1.x = pk2(o[8], o[9]); w1.y = pk2(o[10], o[11]); w1.z = pk2(o[12], o[13]); w1.w = pk2(o[14], o[15]);
      *(LAS v4u*)(L + KS + s * 144 + part * 32) = w0; *(LAS v4u*)(L + KS + s * 144 + part * 32 + 16) = w1; }
    vT_store(L + VT, vr, tid);
    bf16x8 cpf[8][2];
#pragma unroll
    for (int nt = 0; nt < 8; ++nt)
#pragma unroll
        for (int ks = 0; ks < 2; ++ks) cpf[nt][ks] = *(const bf16x8*)(cprev + ((size_t)u * 128 + nt * 16 + fr) * 64 + ks * 32 + fq * 8);
    f32x4 npv = *(const f32x4*)(nprev + (size_t)u * 64 + fr * 4); const float mp0 = mprev[u], mp1 = mprev[512 + u];
    __syncthreads();
    if (w < 2) {
        const int dir = w; LAS float* li = ga + dir * 384; LAS float* lf = li + 128; LAS float* pm = li + 256;
        int pos[2]; float bq[2], xq[2], g; gate_scan(li, lf, dir, lane, pos, bq, xq, g);
        const float m1 = fmaxf(xq[0], xq[1]); float inc = m1;
#pragma unroll
        for (int off = 1; off < 64; off <<= 1) { const float y = shfl_up_l(inc, off, lane); if (lane >= off) inc = fmaxf(inc, y); }
        float exc = shfl_up_l(inc, 1, lane); if (lane == 0) exc = -3.0e38f;
        pm[pos[0]] = fmaxf(exc, xq[0]); pm[pos[1]] = fmaxf(exc, m1);
    }
    __syncthreads();
    f32x4 S[8]; bf16x8 aq[2];
#pragma unroll
    for (int ks = 0; ks < 2; ++ks) aq[ks] = *(const LAS bf16x8*)(L + QS + (16 * w + fr) * 144 + ks * 64 + fq * 16);
#pragma unroll
    for (int nt = 0; nt < 8; ++nt) { f32x4 a = {0.f, 0.f, 0.f, 0.f};
#pragma unroll
        for (int ks = 0; ks < 2; ++ks) { const bf16x8 bk = *(const LAS bf16x8*)(L + KS + (nt * 16 + fr) * 144 + ks * 64 + fq * 16); a = MFMA16(aq[ks], bk, a); }
        S[nt] = a; }
    f32x4 hsum[8], acc[8]; float inter[4], mt[4], den[4];
    m3_dir<0>(L, ga, S, aq, cpf, npv, mp0, acc, inter, mt, den, w, lane);
#pragma unroll
    for (int nt = 0; nt < 8; ++nt)
#pragma unroll
        for (int ks = 0; ks < 2; ++ks) cpf[nt][ks] = *(const bf16x8*)(cprev + (((size_t)512 + u) * 128 + nt * 16 + fr) * 64 + ks * 32 + fq * 8);
    npv = *(const f32x4*)(nprev + ((size_t)512 + u) * 64 + fr * 4);
    m3_pv(L, acc, w, lane);
#pragma unroll
    for (int nt = 0; nt < 8; ++nt)
#pragma unroll
        for (int r = 0; r < 4; ++r) hsum[nt][r] = acc[nt][r] * __builtin_amdgcn_rcpf(fmaxf(fabsf(den[r]), __expf(-mt[r])));
    LDS_FENCE();
    m3_dir<1>(L, ga, S, aq, cpf, npv, mp1, acc, inter, mt, den, w, lane);
    unsigned short zo[4][8];
#pragma unroll
    for (int r = 0; r < 4; ++r)
#pragma unroll
        for (int nt = 0; nt < 8; ++nt) zo[r][nt] = z[(size_t)(t0 + 16 * w + 4 * fq + r) * 2048 + 1536 + hh * 128 + nt * 16 + fr];
    m3_pv(L, acc, w, lane);
#pragma unroll
    for (int nt = 0; nt < 8; ++nt)
#pragma unroll
        for (int r = 0; r < 4; ++r) hsum[nt][r] += acc[nt][r] * __builtin_amdgcn_rcpf(fmaxf(fabsf(den[r]), __expf(-mt[r])));
    __syncthreads();
#pragma unroll
    for (int r = 0; r < 4; ++r) { const int j = 16 * w + 4 * fq + r; const size_t t = (size_t)(t0 + j); float xv[8]; float s1 = 0.f;
#pragma unroll
        for (int nt = 0; nt < 8; ++nt) { xv[nt] = sigmoidf_(bf2f(zo[r][nt])) * hsum[nt][r]; s1 += xv[nt]; }
        s1 += __shfl_xor(s1, 1); s1 += __shfl_xor(s1, 2); s1 += __shfl_xor(s1, 4); s1 += __shfl_xor(s1, 8);
        const float mean = s1 * (1.f / 128.f); float s2 = 0.f;
#pragma unroll
        for (int nt = 0; nt < 8; ++nt) { xv[nt] -= mean; s2 += xv[nt] * xv[nt]; }
        s2 += __shfl_xor(s2, 1); s2 += __shfl_xor(s2, 2); s2 += __shfl_xor(s2, 4); s2 += __shfl_xor(s2, 8);
        const float rstd = rsqrtf(s2 * (1.f / 128.f) + EPS);
#pragma unroll
        for (int nt = 0; nt < 8; ++nt) { const int e = nt * 16 + fr; mix[t * 1024 + 512 + hh * 128 + e] = (bf16)f2bf(xv[nt] * rstd * normg[hh * 128 + e]); } }
    __syncthreads();
}

__device__ __forceinline__ void gmlp_unit(LAS unsigned char* L, int u, const bf16* z, const bf16* wsb, const float* bs, const float* lng, const float* lnb, bf16* mix, int tid_) {
    const int tid = otid(); (void)tid_;
    const int lane = tid & 63, w = tid >> 6, fr = lane & 15, fq = lane >> 4, t0 = u * 128;
    { const int j = tid >> 2, part = tid & 3; const bf16* src = z + (size_t)(t0 + j) * 2048 + 256 + part * 64; float x[64]; float s1 = 0.f;
#pragma unroll
      for (int q = 0; q < 8; ++q) { const v4u w4 = *(const v4u*)(src + 8 * q); const unsigned ww[4] = {w4.x, w4.y, w4.z, w4.w};
#pragma unroll
          for (int i = 0; i < 4; ++i) { x[q * 8 + 2 * i] = geluf_(bflo(ww[i])); x[q * 8 + 2 * i + 1] = geluf_(bfhi(ww[i])); s1 += x[q * 8 + 2 * i] + x[q * 8 + 2 * i + 1]; } }
      s1 += __shfl_xor(s1, 1); s1 += __shfl_xor(s1, 2); const float mean = s1 * (1.f / 256.f); float s2 = 0.f;
#pragma unroll
      for (int i = 0; i < 64; ++i) { x[i] -= mean; s2 += x[i] * x[i]; }
      s2 += __shfl_xor(s2, 1); s2 += __shfl_xor(s2, 2); const float rstd = rsqrtf(s2 * (1.f / 256.f) + EPS);
#pragma unroll
      for (int i = 0; i < 64; ++i) { const int col = part * 64 + i; *(LAS bf16*)(L + col * 272 + j * 2) = (bf16)f2bf(x[i] * rstd * lng[col] + lnb[col]); } }
    __syncthreads();
#pragma unroll 1
    for (int hh = 0; hh < 4; ++hh) { f32x4 acc[4];
#pragma unroll
        for (int nt = 0; nt < 4; ++nt) acc[nt] = (f32x4){0.f, 0.f, 0.f, 0.f};
#pragma unroll
        for (int ks = 0; ks < 4; ++ks) { const bf16x8 a = *(const bf16x8*)(wsb + ((size_t)(hh * 128 + 16 * w + fr) * 128 + ks * 32 + fq * 8));
#pragma unroll
            for (int nt = 0; nt < 4; ++nt) { const bf16x8 bv = *(const LAS bf16x8*)(L + (hh * 64 + nt * 16 + fr) * 272 + ks * 64 + fq * 16); acc[nt] = MFMA16(a, bv, acc[nt]); } }
#pragma unroll
        for (int nt = 0; nt < 4; ++nt)
#pragma unroll
            for (int r = 0; r < 4; ++r) { const int i = 16 * w + 4 * fq + r, d = nt * 16 + fr; const float sv = acc[nt][r] + bs[hh * 128 + i];
                const float uu = geluf_(bf2f(z[(size_t)(t0 + i) * 2048 + hh * 64 + d])); mix[(size_t)(t0 + i) * 1024 + 256 + hh * 64 + d] = (bf16)f2bf(uu * sv); } }
    __syncthreads();
}

__device__ __forceinline__ void phase_route(const Ptrs& P, LAS unsigned char* lds, int layer, int tid_, int vcu, int G) {
    const int tid = otid(); (void)tid_;
    const int lane = tid & 63, wave = tid >> 6;
    LAS int* hist = (LAS int*)lds; LAS int* base = hist + 128; LAS int* pe = hist + 256; LAS int* prank = hist + 768;
    const float* lg = (const float*)(P.ws + WS_LOGIT); const float* rb = P.router_b + layer * NE;
    float* tg = (float*)(P.ws + WS_TOPK); int* list = (int*)(P.ws + WS_LIST);
    unsigned* cursor = (unsigned*)(P.ws + WS_CTL) + CW_CNT + layer * 256;
    const float rb0 = rb[lane], rb1 = rb[64 + lane];
    for (int tb = vcu; tb < T / 64; tb += G) {
        if (tid < 128) hist[tid] = 0;
        __syncthreads();
        LAS float* wv = (LAS float*)(lds + 8192) + wave * 128; LAS float* ssel = (LAS float*)(lds + 8192 + 4096) + wave * 8;
        float nl0 = lg[(size_t)(tb * 64 + wave * 8) * 128 + lane], nl1 = lg[(size_t)(tb * 64 + wave * 8) * 128 + 64 + lane];
#pragma unroll 1
        for (int i = 0; i < 8; ++i) {
            const int t = tb * 64 + wave * 8 + i;
            const float s0 = sigmoidf_(nl0), s1 = sigmoidf_(nl1);
            if (i < 7) { nl0 = lg[(size_t)(t + 1) * 128 + lane]; nl1 = lg[(size_t)(t + 1) * 128 + 64 + lane]; }
            const float v0 = s0 + rb0, v1 = s1 + rb1;
            unsigned k0 = __float_as_uint(v0), k1 = __float_as_uint(v1);
            k0 = (k0 & 0x80000000u) ? ~k0 : (k0 | 0x80000000u); k1 = (k1 & 0x80000000u) ? ~k1 : (k1 | 0x80000000u);
            k0 = (k0 & ~127u) | (unsigned)(127 - lane); k1 = (k1 & ~127u) | (unsigned)(63 - lane);
            LAS unsigned* wk = (LAS unsigned*)wv;
            wk[lane] = k0; wk[64 + lane] = k1;
            LDS_FENCE();
            int r0 = 0, r1 = 0;
#pragma unroll 8
            for (int q = 0; q < 32; ++q) { const v4u o = *(const LAS v4u*)(wk + 4 * q);
                r0 += (o.x > k0) + (o.y > k0) + (o.z > k0) + (o.w > k0); r1 += (o.x > k1) + (o.y > k1) + (o.z > k1) + (o.w > k1); }
            const int lp0 = (wave * 8 + i) * 8;
            if (r0 < 8) { ssel[r0] = s0; pe[lp0 + r0] = lane; prank[lp0 + r0] = __hip_atomic_fetch_add(hist + lane, 1, __ATOMIC_RELAXED, __HIP_MEMORY_SCOPE_WORKGROUP); }
            if (r1 < 8) { ssel[r1] = s1; pe[lp0 + r1] = lane + 64; prank[lp0 + r1] = __hip_atomic_fetch_add(hist + lane + 64, 1, __ATOMIC_RELAXED, __HIP_MEMORY_SCOPE_WORKGROUP); }
            LDS_FENCE();
            const float sum = ((ssel[0] + ssel[1]) + (ssel[2] + ssel[3])) + ((ssel[4] + ssel[5]) + (ssel[6] + ssel[7]));
            if (lane < 8) tg[(size_t)t * 8 + lane] = ssel[lane] / sum;
            LDS_FENCE();
        }
        __syncthreads();
        if (tid < 128) { const int hc = hist[tid]; base[tid] = hc ? (int)__hip_atomic_fetch_add(cursor + tid, (unsigned)hc, __ATOMIC_RELAXED, __HIP_MEMORY_SCOPE_AGENT) : 0; }
        __syncthreads();
        { const int e = pe[tid]; list[(size_t)e * LCAP + base[e] + prank[tid]] = tb * 512 + tid; }
        __syncthreads();
    }
}
__device__ __forceinline__ void compute_blkoff(const Ptrs& P, LAS int* tbl, int layer, int tid_) {
    const int tid = otid(); (void)tid_;
    __syncthreads();
    if (tid < 128) tbl[132 + tid] = (int)__hip_atomic_load((const unsigned*)(P.ws + WS_CTL) + CW_CNT + layer * 256 + tid, __ATOMIC_RELAXED, __HIP_MEMORY_SCOPE_AGENT);
    __syncthreads();
    if (tid == 0) { int o = 0; for (int e = 0; e < 128; ++e) { tbl[e] = o; o += (tbl[132 + e] + 255) >> 8; } tbl[128] = o; }
    __syncthreads();
}

__device__ __forceinline__ int moe_prepare(const LAS int* tbl, LAS int* desc, LAS int* rowtab, const int* list, int nct, int G, int c, int pnbase) {
    const int tid = otid();
    const int total = __builtin_amdgcn_readfirstlane(tbl[128]) * nct; int n = 0;
    for (int L = c; L < total; L += G, ++n) {
        const int rb = L / nct, ct = L % nct; int lo = 0, hi = 128;
        while (hi - lo > 1) { const int mid = (lo + hi) >> 1; if (__builtin_amdgcn_readfirstlane(tbl[mid]) <= rb) lo = mid; else hi = mid; }
        const int rbl = rb - __builtin_amdgcn_readfirstlane(tbl[lo]); int nv = __builtin_amdgcn_readfirstlane(tbl[132 + lo]) - rbl * 256; nv = nv > 256 ? 256 : nv;
        if (tid < 256) rowtab[n * 256 + tid] = (tid < nv) ? list[(size_t)lo * LCAP + rbl * 256 + tid] : 0;
        if (tid == 0) { desc[3 * n] = (pnbase + lo) * nct + ct; desc[3 * n + 1] = nv; desc[3 * n + 2] = rb; }
    }
    __syncthreads();
    return n;
}

struct Args { const float* in[26]; float* out; unsigned char* ws; int ph_lo, ph_hi, li, pad; };
constexpr int N_PHASES = 2 + NL * 13 + 1;

__global__ void __launch_bounds__(NTHR, 2) mk_fwd(Args args) {
    extern __shared__ __attribute__((aligned(16))) unsigned char lds_raw[];
    LAS unsigned char* lds = (LAS unsigned char*)lds_raw;
    const int G = gridDim.x;
    const int vcu = (G % 8 == 0) ? ((int)blockIdx.x % 8) * (G / 8) + (int)blockIdx.x / 8 : (int)blockIdx.x;
    volatile LAS unsigned* MISC = (volatile LAS unsigned*)(lds + LDS_MISC);
    LAS int* blkoff = (LAS int*)(lds + LDS_TBL);
    if (threadIdx.x < 4) MISC[threadIdx.x] = 0u;
    __syncthreads();
    XcdBarrier bar; bar.bar = (unsigned*)(args.ws + WS_CTL) + CW_BAR + args.li * XCD_BAR_WORDS; bar.x = 0; bar.st = nullptr;
#if !MK_SPLIT
    bar = xcd_barrier_post((unsigned*)(args.ws + WS_CTL) + CW_BAR + args.li * XCD_BAR_WORDS, MISC);
#endif
    const int lo = args.ph_lo, hi = args.ph_hi;
#define IN(k) (lo <= (k) && (k) < hi)
#if MK_SPLIT
#define SEAM(k) do { } while (0)
#else
#define SEAM(k) do { if ((k) + 1 < hi) xcd_barrier(bar); } while (0)
#endif
#define PTRS() Ptrs P; load_ptrs(P); unsigned char* const ws = P.ws; (void)ws

    if (EN(0) && IN(0)) { PTRS(); phase_p0a(P, lds, 0, vcu, G); SEAM(0); }
    if (EN(1) && IN(1)) {
        PTRS();
        phase_p0b_fold(P, lds, 0, vcu, G);
        { pg8::Gemm g{(const bf16*)(ws + WS_PB), (const bf16*)(ws + WS_PLEIN), NL * T, NL * 1024, 256}; StackOrder S{NL, 64, 4, G, vcu};
          EpiStoreBf16 E{(bf16*)(ws + WS_E), 1024, 3}; pg8::gemm_phase<EpiStoreBf16, StackOrder, GEMM_ALIGN, GEMM_SP2>(lds, g, S, E); }
        SEAM(1);
    }
#pragma unroll 1
    for (int layer = 0; layer < NL; ++layer) {
        const int k0 = 2 + layer * 13;
        if (EN(2) && IN(k0 + 0)) { PTRS(); if (layer == 0) phase_rowpass1<0>(P, lds, layer, 0, vcu, G); else phase_rowpass1<1>(P, lds, layer, 0, vcu, G); SEAM(k0 + 0); }
        if (EN(3) && IN(k0 + 1)) {
            PTRS();
            { pg8::Gemm g{(const bf16*)(ws + WS_XM), (const bf16*)(ws + WS_WIN) + (size_t)layer * 2048 * 1024, T, 2048, 1024}; pg8::StaticOrder S; S.init(T, 2048, G, (int)blockIdx.x);
              EpiStoreBf16 E{(bf16*)(ws + WS_Z), 2048, 0xffff}; pg8::gemm_phase<EpiStoreBf16, pg8::StaticOrder, GEMM_ALIGN, GEMM_SP2>(lds, g, S, E); }
            SEAM(k0 + 1);
        }
        if (EN(4) && IN(k0 + 2)) {
            if (G == 256 ? ((int)blockIdx.x >= 128) : true) {
                PTRS();
                pg8::Gemm g{(const bf16*)(ws + WS_WPQ) + (size_t)layer * 512 * 1024, (const bf16*)(ws + WS_XM), 512, T, 1024}; pg8::StaticOrder S;
                if (G == 256) S.init(512, T, 128, (int)blockIdx.x - 128); else S.init(512, T, G, (int)blockIdx.x);
                EpiPQ E{(bf16*)(ws + WS_PQT)}; pg8::gemm_phase<EpiPQ, pg8::StaticOrder, GEMM_ALIGN, GEMM_SP2>(lds, g, S, E);
            }
            PTRS();
            for (int it = (int)blockIdx.x; it < 128 + 512; it += G) {
                if (it < 128) { if (L3MASK & 2) gmlp_unit(lds, it, (const bf16*)(ws + WS_Z), (const bf16*)(ws + WS_GWS) + (size_t)layer * 4 * 128 * 128, P.gmlp_bs + (size_t)layer * 512, P.gmlp_ln_g + (size_t)layer * 256, P.gmlp_ln_b + (size_t)layer * 256, (bf16*)(ws + WS_MIX), 0); }
                else if (L3MASK & 4) m1_unit(lds, it - 128, (const bf16*)(ws + WS_Z), (const float*)(ws + WS_GATES), P.conv_w + (size_t)layer * 3 * 512, (float*)(ws + WS_CLOC), (float*)(ws + WS_SMALL), (float*)(ws + WS_SMALL) + 131072, 0);
            }
            SEAM(k0 + 2);
        }
        if (EN(5) && IN(k0 + 3)) { PTRS(); phase_m2(P, 0, vcu, G); phase_pqfold(P, 0, vcu, G); SEAM(k0 + 3); }
        if (EN(6) && IN(k0 + 4)) {
            const int nf = (G >= 128) ? 64 : 0;
            if ((int)blockIdx.x < 64 || nf == 0) {
                PTRS();
                pg8::Gemm g{(const bf16*)(ws + WS_DFT), (const bf16*)(ws + WS_PQF), 2048, 2048, 2048}; pg8::StaticOrder S; S.init(2048, 2048, nf ? 64 : G, (int)blockIdx.x);
                EpiFourier E{(bf16*)(ws + WS_MIX)}; pg8::gemm_phase<EpiFourier, pg8::StaticOrder, GEMM_ALIGN, GEMM_SP2>(lds, g, S, E);
            }
            {
                PTRS();
                const int nm = 512 - nf;
                int u0, ustep, uend;
                if ((int)blockIdx.x < nf) { u0 = nm + (int)blockIdx.x; ustep = 512; uend = 512; } else { u0 = (int)blockIdx.x - nf; ustep = G - nf; uend = nm; }
                for (int u = u0; u < uend; u += ustep) m3_unit(lds, u, (const bf16*)(ws + WS_Z), (const float*)(ws + WS_GATES), P.conv_w + (size_t)layer * 3 * 512, (const bf16*)(ws + WS_CPREV), (const float*)(ws + WS_SMALL) + 65536, (const float*)(ws + WS_SMALL) + 131072 + 2048, P.mnorm_g + (size_t)layer * 512, (bf16*)(ws + WS_MIX), 0);
            }
            SEAM(k0 + 4);
        }
        if (EN(7) && IN(k0 + 5)) {
            PTRS();
            pg8::Gemm g{(const bf16*)(ws + WS_MIX), (const bf16*)(ws + WS_WOUT) + (size_t)layer * 1024 * 1024, T, 1024, 1024}; pg8::StaticOrder S; S.init(T, 1024, G, (int)blockIdx.x);
            EpiResid E{(float*)(ws + WS_H)}; pg8::gemm_phase<EpiResid, pg8::StaticOrder, GEMM_ALIGN, GEMM_SP2>(lds, g, S, E);
            SEAM(k0 + 5);
        }
        if (EN(8) && IN(k0 + 6)) { PTRS(); phase_rowpass2(P, layer, 0, vcu, G); SEAM(k0 + 6); }
        if (EN(9) && IN(k0 + 7)) {
            PTRS();
            pg8::Gemm g{(const bf16*)(ws + WS_XM), (const bf16*)(ws + WS_RS + (size_t)layer * RS_L), T, 768, 1024}; pg8::StaticOrder S; S.init(T, 768, G, (int)blockIdx.x);
            EpiRouterShared E{(float*)(ws + WS_LOGIT), (bf16*)(ws + WS_ACT)}; pg8::gemm_phase<EpiRouterShared, pg8::StaticOrder, GEMM_ALIGN, GEMM_SP2>(lds, g, S, E);
            SEAM(k0 + 7);
        }
        if (EN(10) && IN(k0 + 8)) { PTRS(); phase_route(P, lds, layer, 0, vcu, G); SEAM(k0 + 8); }
        if (EN(12) && IN(k0 + 9)) {
            PTRS();
            compute_blkoff(P, blkoff, layer, 0);
            LAS int* desc = (LAS int*)(lds + LDS_DESC); LAS int* rowtab = (LAS int*)(lds + LDS_ROWTAB);
            { pg8::Gemm g{(const bf16*)(ws + WS_XM8), (const bf16*)(ws + WS_WGU + (size_t)layer * WGU_L), T, 128 * 512, 1024};
              const int nun = moe_prepare(blkoff, desc, rowtab, (const int*)(ws + WS_LIST), 2, G, vcu, 0);
              stagger(vcu & 3, STAG_GU);
              MoeOrder<0> S{desc, rowtab, nun, 3, 1024u, nullptr};
              EpiSwigluScatter E{(unsigned char*)(ws + WS_ACT) + ACT8_OFF, rowtab, 1.f / (SX8 * SW8)}; pg8::gemm_phase<EpiSwigluScatter, MoeOrder<0>, GEMM_ALIGN, GEMM_SP2, true>(lds, g, S, E); }
            {
              const int n5 = (__builtin_amdgcn_readfirstlane(blkoff[128]) * 2) & 255, idx = vcu - n5;
              int st = vcu, cn = 1; if (n5 <= 128) { st = 2 * idx; cn = (idx >= 0 && idx < 128) ? 2 : 0; }
              pg8::Gemm g{(const bf16*)(ws + WS_ACT), (const bf16*)(ws + WS_WD + (size_t)layer * WD_L), T, 1024, 256}; RangeOrder S{st, cn, 4};
              EpiStoreBf16 E{(bf16*)(ws + WS_Y), 1024, 3}; pg8::gemm_phase<EpiStoreBf16, RangeOrder, GEMM_ALIGN, GEMM_SP2>(lds, g, S, E); }
            SEAM(k0 + 9);
        }
        if (EN(13) && IN(k0 + 10)) {
            PTRS();
            compute_blkoff(P, blkoff, layer, 0);
            LAS int* desc = (LAS int*)(lds + LDS_DESC); LAS int* rowtab = (LAS int*)(lds + LDS_ROWTAB);
            pg8::Gemm g{(const bf16*)(ws + WS_ACT + ACT8_OFF), (const bf16*)(ws + WS_WD + (size_t)layer * WD_L + WD8_OFF), T * 8, 128 * 1024, 256};
            const int nun = moe_prepare(blkoff, desc, rowtab, (const int*)(ws + WS_LIST), 4, G, vcu, 0);
            stagger(vcu & 3, STAG_D);
            MoeOrder<0> S{desc, rowtab, nun, 0, 256u, nullptr};
            EpiYScatter E{(unsigned char*)(ws + WS_Y) + (size_t)T * 1024 * 2, rowtab, 16.f / (SA8 * SW8)}; pg8::gemm_phase<EpiYScatter, MoeOrder<0>, GEMM_ALIGN, GEMM_SP2, true>(lds, g, S, E);
            SEAM(k0 + 10);
        }
        if (EN(14) && IN(k0 + 11)) { PTRS(); phase_combine(P, 0, vcu, G); SEAM(k0 + 11); }
        if (EN(15) && IN(k0 + 12)) {
            PTRS();
            pg8::Gemm g{(const bf16*)(ws + WS_HB), (const bf16*)(ws + WS_PLEG) + (size_t)layer * 1024 * 1024, T, 1024, 1024}; pg8::StaticOrder S; S.init(T, 1024, G, (int)blockIdx.x);
            EpiPleGate E{(bf16*)(ws + WS_GE), (const bf16*)(ws + WS_E) + (size_t)layer * T * 1024}; pg8::gemm_phase<EpiPleGate, pg8::StaticOrder, GEMM_ALIGN, GEMM_SP2>(lds, g, S, E);
            SEAM(k0 + 12);
        }
    }
    if (EN(16) && IN(N_PHASES - 1)) { PTRS(); phase_rowpass1<2>(P, lds, NL, 0, vcu, G); }
#undef IN
#undef SEAM
#undef PTRS
}

extern "C" void kernel_launch(void* const* d_in, const int* in_sizes, int n_in, void* d_out, int out_size, void* d_ws, size_t ws_size, hipStream_t stream) {
    static int grid = 0;
    if (grid == 0) {
        if (n_in != 26 || ws_size < WS_END) { fprintf(stderr, "kernel_launch: need 26 inputs and %zu bytes of workspace (got %d, %zu)\n", (size_t)WS_END, n_in, ws_size); grid = -1; return; }
        int dev = 0, cus = 0, per_cu = 0;
        if (hipGetDevice(&dev) != hipSuccess || hipDeviceGetAttribute(&cus, hipDeviceAttributeMultiprocessorCount, dev) != hipSuccess) { grid = -1; return; }
        if (hipFuncSetAttribute((const void*)mk_fwd, hipFuncAttributeMaxDynamicSharedMemorySize, LDS_BYTES) != hipSuccess) { fprintf(stderr, "kernel_launch: hipFuncSetAttribute failed\n"); grid = -1; return; }
        if (hipOccupancyMaxActiveBlocksPerMultiprocessor(&per_cu, (const void*)mk_fwd, NTHR, LDS_BYTES) != hipSuccess || per_cu < 1) fprintf(stderr, "kernel_launch: occupancy query says %d\n", per_cu);
        (void)hipGetLastError();
        grid = cus;
    }
    if (grid < 0) return;
    (void)hipMemsetAsync((char*)d_ws + WS_CTL, 0, CTL_BYTES, stream);
    Args a{};
    for (int i = 0; i < 26; ++i) a.in[i] = (const float*)d_in[i];
    a.out = (float*)d_out; a.ws = (unsigned char*)d_ws; a.pad = 0;
#if MK_SPLIT
    for (int ph = 0; ph < N_PHASES; ++ph) { a.ph_lo = ph; a.ph_hi = ph + 1; a.li = 0; hipLaunchKernelGGL(mk_fwd, dim3(grid), dim3(NTHR), LDS_BYTES, stream, a); }
#else
    a.ph_lo = 0; a.ph_hi = N_PHASES; a.li = 0;
    hipLaunchKernelGGL(mk_fwd, dim3(grid), dim3(NTHR), LDS_BYTES, stream, a);
#endif
    const hipError_t le = hipPeekAtLastError();
    if (le != hipSuccess) fprintf(stderr, "kernel_launch: launch failed: %s\n", hipGetErrorName(le));
}
```
